# Optimizing an MI355X kernel written in HIP

```python
import jax
import jax.numpy as jnp
from jax import lax
import numpy as np

D_MODEL = 1024
BATCH = 2
SEQ = 8192
DEPTH = 1

D_MIX = D_MODEL
GLA_HEADS = 4
GLA_DV = (D_MIX // 2) // GLA_HEADS
GLA_DK = GLA_DV // 2
GLA_LOWRANK = 16
GLA_TAU = 16.0
GLA_CHUNK = 16
ATT_HEADS = 8
ATT_HD = (D_MIX - GLA_HEADS * GLA_DV) // ATT_HEADS
DILATIONS = ((128, 1), (512, 4), (2048, 16))
ATT_BLOCK = 128
N_GROUPS = 4
EXPERTS_PER_GROUP = 8
N_EXPERTS = N_GROUPS * EXPERTS_PER_GROUP
TOP_K = 2
D_FF_EXPERT = 512
MOE_BLOCK = 128
EPS = 1e-6

GLA_QK = GLA_HEADS * GLA_DK
GLA_V = GLA_HEADS * GLA_DV
ATT_W = ATT_HEADS * ATT_HD
IN_SIZES = (GLA_QK, GLA_QK, GLA_V, GLA_V, GLA_LOWRANK, ATT_W, ATT_W, ATT_W)
IN_SPLITS = tuple(sum(IN_SIZES[:i + 1]) for i in range(len(IN_SIZES) - 1))
IN_COLS = sum(IN_SIZES)

kernel_name = 'hymba_gla_dilated_hmoe'


def rmsnorm(x, g):
    xf = x.astype(jnp.float32)
    y = xf * lax.rsqrt(jnp.mean(xf * xf, axis=-1, keepdims=True) + EPS)
    return (y * g.astype(jnp.float32)).astype(x.dtype)


def gla_chunked(q, k, v, log_a):
    B, T, H, DK = q.shape
    DV = v.shape[-1]
    C = GLA_CHUNK
    N = T // C

    def chunks(t):
        return t.astype(jnp.float32).reshape(B, N, C, H, t.shape[-1]).transpose(0, 3, 1, 2, 4)

    q = chunks(q) * (DK ** -0.5)
    k, v, la = chunks(k), chunks(v), chunks(log_a)
    G = jnp.cumsum(la, axis=3)
    causal = jnp.tril(jnp.ones((C, C), dtype=bool))[:, :, None]
    diff = G[:, :, :, :, None, :] - G[:, :, :, None, :, :]
    decay = jnp.where(causal, jnp.exp(jnp.where(causal, diff, 0.0)), 0.0)
    A = jnp.einsum('bhnid,bhnjd,bhnijd->bhnij', q, k, decay)
    o_intra = jnp.einsum('bhnij,bhnjv->bhniv', A, v)
    G_last = G[:, :, :, -1:, :]
    U = jnp.einsum('bhncd,bhncv->bhndv', k * jnp.exp(G_last - G), v)
    a_chunk = jnp.exp(G_last[:, :, :, 0, :])

    def step(S, inp):
        a, u = inp
        return a[..., None] * S + u, S

    S0 = jnp.zeros((B, H, DK, DV), jnp.float32)
    _, S_prev = lax.scan(step, S0, (jnp.moveaxis(a_chunk, 2, 0), jnp.moveaxis(U, 2, 0)))
    S_prev = jnp.moveaxis(S_prev, 0, 2)
    o_inter = jnp.einsum('bhncd,bhndv->bhncv', q * jnp.exp(G), S_prev)
    o = o_intra + o_inter
    return o.transpose(0, 2, 3, 1, 4).reshape(B, T, H, DV)


def dilated_branch(q, k, v, window, dilation):
    B, H, T, D = q.shape
    d = dilation
    L = T // d
    n_back = window // d
    P = ATT_BLOCK
    nb = -(-L // P)
    Lp = nb * P

    def phase(t):
        t = t.reshape(B, H, L, d, D).transpose(0, 1, 3, 2, 4)
        t = jnp.pad(t, ((0, 0), (0, 0), (0, 0), (0, Lp - L), (0, 0)))
        return t.reshape(B, H, d, nb, P, D)

    def with_prev(t):
        prev = jnp.concatenate([jnp.zeros_like(t[:, :, :, :1]), t[:, :, :, :-1]], axis=3)
        return jnp.concatenate([prev, t], axis=4)

    qb = phase(q)
    kb, vb = with_prev(phase(k)), with_prev(phase(v))
    s = jnp.einsum('bhrnqd,bhrnkd->bhrnqk', qb, kb) * (D ** -0.5)
    blk = jnp.arange(nb)[:, None, None]
    qpos = jnp.arange(P)[None, :, None] + P
    kpos = jnp.arange(2 * P)[None, None, :]
    dist = qpos - kpos
    valid = (dist >= 0) & (dist <= n_back) & (blk * P + kpos - P >= 0)
    s = jnp.where(valid, s, -jnp.inf)
    m = jnp.max(s, axis=-1)
    p = jnp.exp(s - m[..., None])
    den = jnp.sum(p, axis=-1)
    o = jnp.einsum('bhrnqk,bhrnkd->bhrnqd', p, vb) / den[..., None]

    def unphase(t):
        rest = t.shape[5:]
        t = t.reshape((B, H, d, Lp) + rest)[:, :, :, :L]
        t = jnp.moveaxis(t, 2, 3)
        return t.reshape((B, H, T) + rest)

    return unphase(o), unphase(m), unphase(den)


def hybrid_mixer(n, w_in, gla_gate_w2, gla_gate_b, gla_norm_g, w_out):
    B, T, _ = n.shape
    proj = n @ w_in
    gq, gk, gv, gr, glr, aq, ak, av = jnp.split(proj, IN_SPLITS, axis=-1)
    log_a = jax.nn.log_sigmoid((glr @ gla_gate_w2 + gla_gate_b).astype(jnp.float32)) / GLA_TAU
    heads = lambda t: t.reshape(B, T, GLA_HEADS, -1)
    o_gla = gla_chunked(heads(gq), heads(gk), heads(gv), heads(log_a))
    o_gla = o_gla * lax.rsqrt(jnp.mean(o_gla * o_gla, axis=-1, keepdims=True) + EPS) * gla_norm_g.astype(jnp.float32)
    o_gla = o_gla.reshape(B, T, GLA_V) * jax.nn.silu(gr.astype(jnp.float32))
    to_bhtd = lambda t: t.astype(jnp.float32).reshape(B, T, ATT_HEADS, ATT_HD).transpose(0, 2, 1, 3)
    q, k, v = to_bhtd(aq), to_bhtd(ak), to_bhtd(av)
    branches = [dilated_branch(q, k, v, w, d) for (w, d) in DILATIONS]
    o_all = jnp.stack([br[0] for br in branches])
    m_all = jnp.stack([br[1] for br in branches])
    den_all = jnp.stack([br[2] for br in branches])
    wts = den_all * jnp.exp(m_all - jnp.max(m_all, axis=0, keepdims=True))
    o_att = jnp.sum(wts[..., None] * o_all, axis=0) / jnp.sum(wts, axis=0)[..., None]
    o_att = o_att.transpose(0, 2, 1, 3).reshape(B, T, ATT_W)
    o = jnp.concatenate([o_gla, o_att], axis=-1).astype(n.dtype)
    return o @ w_out


def hier_moe(n, w_grp, b_grp, w_exp, b_exp, w1, w3, w2):
    B, T, D = n.shape
    M = B * T
    x = n.reshape(M, D)
    g_logits = (x @ w_grp).astype(jnp.float32) + b_grp.astype(jnp.float32)
    g_idx = jnp.argmax(g_logits, axis=-1).astype(jnp.int32)
    g_prob = jnp.take_along_axis(jax.nn.softmax(g_logits, axis=-1), g_idx[:, None], axis=-1)
    e_logits = ((x @ w_exp).astype(jnp.float32) + b_exp.astype(jnp.float32)).reshape(M, N_GROUPS, EXPERTS_PER_GROUP)
    e_logits = jnp.take_along_axis(e_logits, g_idx[:, None, None], axis=1)[:, 0]
    top_v, top_i = lax.top_k(e_logits, TOP_K)
    gate = jax.nn.softmax(top_v, axis=-1) * g_prob
    expert_id = g_idx[:, None] * EXPERTS_PER_GROUP + top_i.astype(jnp.int32)
    A = M * TOP_K
    e_flat = expert_id.reshape(A)
    tok_flat = jnp.repeat(jnp.arange(M, dtype=jnp.int32), TOP_K)
    order = jnp.argsort(e_flat)
    e_s, tok_s, w_s = e_flat[order], tok_flat[order], gate.reshape(A)[order]
    counts = jnp.bincount(e_flat, length=N_EXPERTS)
    start = jnp.cumsum(counts) - counts
    padded = (counts + MOE_BLOCK - 1) // MOE_BLOCK * MOE_BLOCK
    p_end = jnp.cumsum(padded)
    dest = (p_end - padded)[e_s] + jnp.arange(A) - start[e_s]
    R = (-(-A // MOE_BLOCK) + N_EXPERTS) * MOE_BLOCK
    n_blk = R // MOE_BLOCK
    row_tok = jnp.zeros((R,), jnp.int32).at[dest].set(tok_s)
    row_w = jnp.zeros((R,), jnp.float32).at[dest].set(w_s)
    blk_exp = jnp.minimum(jnp.searchsorted(p_end, jnp.arange(n_blk) * MOE_BLOCK, side='right'), N_EXPERTS - 1)

    def expert_block(args):
        toks, e = args
        xb = x[toks]
        hb = jax.nn.silu(xb @ w1[e]) * (xb @ w3[e])
        return hb @ w2[e]

    y = lax.map(expert_block, (row_tok.reshape(n_blk, MOE_BLOCK), blk_exp))
    y = y.reshape(R, D).astype(jnp.float32) * row_w[:, None]
    out = jnp.zeros((M, D), jnp.float32).at[row_tok].add(y)
    return out.astype(n.dtype).reshape(B, T, D)


def setup_inputs(seed: int = 0) -> dict:
    key = jax.random.key(seed)
    ks = jax.random.split(key, 17)
    nrm = jax.random.normal
    f = jnp.float32
    return {
        'x': nrm(ks[0], (BATCH, SEQ, D_MODEL), f),
        'norm1_g': 1.0 + 0.02 * nrm(ks[1], (DEPTH, D_MODEL), f),
        'w_in': nrm(ks[2], (DEPTH, D_MODEL, IN_COLS), f) * D_MODEL ** -0.5,
        'gla_gate_w2': nrm(ks[3], (DEPTH, GLA_LOWRANK, GLA_QK), f) * GLA_LOWRANK ** -0.5,
        'gla_gate_b': 0.1 * nrm(ks[4], (DEPTH, GLA_QK), f),
        'gla_norm_g': 1.0 + 0.02 * nrm(ks[5], (DEPTH, GLA_DV), f),
        'w_out': nrm(ks[6], (DEPTH, D_MIX, D_MODEL), f) * D_MIX ** -0.5,
        'norm2_g': 1.0 + 0.02 * nrm(ks[7], (DEPTH, D_MODEL), f),
        'router_group_w': nrm(ks[8], (DEPTH, D_MODEL, N_GROUPS), f) * D_MODEL ** -0.5,
        'router_group_b': 0.01 * nrm(ks[9], (DEPTH, N_GROUPS), f),
        'router_expert_w': nrm(ks[10], (DEPTH, D_MODEL, N_EXPERTS), f) * D_MODEL ** -0.5,
        'router_expert_b': 0.01 * nrm(ks[11], (DEPTH, N_EXPERTS), f),
        'expert_w1': nrm(ks[12], (DEPTH, N_EXPERTS, D_MODEL, D_FF_EXPERT), f) * D_MODEL ** -0.5,
        'expert_w3': nrm(ks[13], (DEPTH, N_EXPERTS, D_MODEL, D_FF_EXPERT), f) * D_MODEL ** -0.5,
        'expert_w2': nrm(ks[14], (DEPTH, N_EXPERTS, D_FF_EXPERT, D_MODEL), f) * D_FF_EXPERT ** -0.5,
        'final_norm_g': 1.0 + 0.02 * nrm(ks[15], (D_MODEL,), f),
    }


def reference(x, norm1_g, w_in, gla_gate_w2, gla_gate_b, gla_norm_g, w_out, norm2_g,
              router_group_w, router_group_b, router_expert_w, router_expert_b,
              expert_w1, expert_w3, expert_w2, final_norm_g):
    h = x
    for l in range(DEPTH):
        h = h + hybrid_mixer(rmsnorm(h, norm1_g[l]), w_in[l], gla_gate_w2[l], gla_gate_b[l],
                             gla_norm_g[l], w_out[l])
        h = h + hier_moe(rmsnorm(h, norm2_g[l]), router_group_w[l], router_group_b[l],
                         router_expert_w[l], router_expert_b[l],
                         expert_w1[l], expert_w3[l], expert_w2[l])
    return rmsnorm(h, final_norm_g)
```

```cpp
#include <hip/hip_runtime.h>
#include <stdint.h>
#include <stdio.h>

typedef unsigned short bf16;
typedef short bf16x8 __attribute__((ext_vector_type(8)));
typedef float f32x4 __attribute__((ext_vector_type(4)));

__device__ __forceinline__ float bf2f(bf16 b) { return __uint_as_float(((unsigned)b) << 16); }
__device__ __forceinline__ bf16 f2bf(float f) { unsigned u = __float_as_uint(f); u += 0x7fffu + ((u >> 16) & 1u); return (bf16)(u >> 16); }

constexpr int BATCH = 2, T = 8192, M = BATCH * T, D = 1024;
constexpr int INC = 3088;
constexpr int NPROJ = 3072;
constexpr int C_GQ = 0, C_GK = 256, C_GV = 512, C_GR = 1024, C_AQ = 1536, C_AK = 2048, C_AV = 2560;
constexpr int GLR_SRC = 1536;
constexpr int NE = 32, FF = 512;
constexpr float EPS = 1e-6f;
constexpr int LIST_CAP = 16384;

constexpr size_t MiB = 1u << 20;
constexpr size_t WS_CTL = 0, CTL_BYTES = 1 * MiB;
constexpr size_t WS_WRT = 1 * MiB;
constexpr size_t WS_WOUT = 2 * MiB;
constexpr size_t WS_W13 = 4 * MiB;
constexpr size_t WS_W2 = 68 * MiB;
constexpr size_t WS_R = 100 * MiB;
constexpr size_t WS_WIN = WS_R;
constexpr size_t WS_GLR = WS_R + 6 * MiB;
constexpr size_t WS_GLAS = WS_R + 7 * MiB;
constexpr size_t WS_N1 = WS_R + 16 * MiB;
constexpr size_t WS_O = WS_N1;
constexpr size_t WS_PROJ = WS_R + 48 * MiB;
constexpr size_t WS_Y = WS_R;
constexpr size_t WS_N2 = WS_R + 64 * MiB;
constexpr size_t WS_HID = WS_R + 96 * MiB;
constexpr size_t WS_ROUTE = WS_R + 136 * MiB;
constexpr size_t WS_RSTD = WS_ROUTE + 512 * 1024;
constexpr size_t WS_LIST = WS_R + 137 * MiB;
constexpr size_t WS_LRS = WS_R + 139 * MiB;
constexpr size_t WS_LGW = WS_R + 141 * MiB;
constexpr size_t WS_END = WS_R + 144 * MiB;
constexpr int CW_CNT = 64;

struct Route { int e0, e1; float w0, w1; };

__device__ __forceinline__ float wave_sum(float v) {
#pragma unroll
    for (int o = 1; o < 64; o <<= 1) v += __shfl_xor(v, o);
    return v;
}
__device__ __forceinline__ float logsigmoid(float z) { return fminf(z, 0.f) - log1pf(__expf(-fabsf(z))); }
#define LAS __attribute__((address_space(3)))
#define GAS __attribute__((address_space(1)))
typedef unsigned u32x4 __attribute__((ext_vector_type(4)));
typedef unsigned u32x2 __attribute__((ext_vector_type(2)));
namespace pg8 {
constexpr int BM = 256, BK = 64, HALF = 128, HTB = HALF * BK * 2, STAGE_BYTES = 8 * HTB, NXCD = 8, WGM = 8;
__host__ __device__ __forceinline__ int lds_byte(int r, int c) { const int st = (r >> 4) * 2 + (c >> 5), rr = r & 15, cc = c & 31, ob = rr * 64 + cc * 2; return st * 1024 + (ob ^ (((ob >> 9) & 1) << 5)); }
__host__ __device__ __forceinline__ void stage_rc(int b, int& R, int& C) { const int st = b / 1024, sb = b % 1024, swz = sb ^ (((sb >> 9) & 1) << 5); R = (st >> 1) * 16 + swz / 64; C = (st & 1) * 32 + (swz % 64) / 2; }
__host__ __device__ __forceinline__ int perm32(int rho) { const int n = rho >> 4, i = rho & 15; return 8 * (i >> 2) + 4 * n + (i & 3); }
struct Unit { int pm, pn, e, nrows; };
typedef float f32x2_t __attribute__((ext_vector_type(2))); typedef __bf16 bf16x2_t __attribute__((ext_vector_type(2)));
__device__ __forceinline__ unsigned cvt_pk_bf16(float lo, float hi) { const f32x2_t v = {lo, hi}; const bf16x2_t b = __builtin_convertvector(v, bf16x2_t); return __builtin_bit_cast(unsigned, b); }

__device__ __forceinline__ void st16_wt(void* p, u32x4 v) { asm volatile("global_store_dwordx4 %0, %1, off sc1\n\ts_nop 1" :: "v"(p), "v"(v) : "memory"); }

struct DenseOrder {
    int nM, nN, nwg, G, c, K; const char* A; const char* Bt;
    __device__ void init(const void* A_, const void* Bt_, int M_, int N_, int K_, int G_, int c_) { A = (const char*)A_; Bt = (const char*)Bt_; nM = M_ / BM; nN = N_ / BM; nwg = nM * nN; G = G_; c = c_; K = K_; }
    __device__ __forceinline__ bool next(int i, Unit& u) const {
        const long L = (long)i * G + c; if (L >= nwg) return false;
        int wgid = (int)L; { const int q = nwg / NXCD, r = nwg % NXCD, xcd = wgid % NXCD, off = wgid / NXCD; wgid = (xcd < r ? xcd * (q + 1) : r * (q + 1) + (xcd - r) * q) + off; }
        const int nig = WGM * nN, gid = wgid / nig, fm = gid * WGM, gsz = (nM - fm) < WGM ? (nM - fm) : WGM;
        u.pm = fm + ((wgid % nig) % gsz); u.pn = (wgid % nig) / gsz; u.e = 0; u.nrows = 256; return true;
    }
    __device__ __forceinline__ void a_off(const Unit& u, const int (&R)[2], const int (&C)[2], unsigned (&off)[2][2]) const {
#pragma unroll
        for (int h = 0; h < 2; ++h)
#pragma unroll
            for (int i = 0; i < 2; ++i) off[h][i] = (unsigned)(((u.pm * BM + h * HALF + R[i]) * K + C[i]) * 2);
    }
    __device__ __forceinline__ const char* a_base() const { return A; }
    __device__ __forceinline__ const char* b_base(const Unit& u) const { return Bt + (size_t)u.pn * BM * K * 2; }
};

struct EpiBf16 {
    static constexpr bool PERM = true;
    bf16* O; int ldc;
    __device__ __forceinline__ void operator()(const f32x4 (&acc)[2][2][4][2], const Unit& u, int wr, int wc, int fr, int fq) const {
        const int row0 = u.pm * BM + wr * 64 + fr, col0 = u.pn * BM + wc * 32 + 8 * fq;
#pragma unroll
        for (int ai = 0; ai < 2; ++ai)
#pragma unroll
            for (int m = 0; m < 4; ++m) { bf16* rowp = O + (size_t)(row0 + ai * HALF + m * 16) * ldc + col0;
#pragma unroll
                for (int bj = 0; bj < 2; ++bj) { const f32x4 v0 = acc[ai][bj][m][0], v1 = acc[ai][bj][m][1];
                    u32x4 w; w.x = cvt_pk_bf16(v0[0], v0[1]); w.y = cvt_pk_bf16(v0[2], v0[3]); w.z = cvt_pk_bf16(v1[0], v1[1]); w.w = cvt_pk_bf16(v1[2], v1[3]);
                    st16_wt(rowp + bj * HALF, w); } }
    }
};

template <class Epi, class Sched, bool ALIGN_EPI>
__device__ __forceinline__ void gemm_phase(LAS unsigned char* lds, int K, const Sched& S, const Epi& E) {
    const int tid = threadIdx.x, wid = __builtin_amdgcn_readfirstlane(tid >> 6), lane = tid & 63, wr = wid >> 2, wc = wid & 3, fr = lane & 15, fq = lane >> 4;
    const int nt = K / BK;
    int Rr[2], Cc[2]; unsigned voffB[2];
#pragma unroll
    for (int i = 0; i < 2; ++i) { int R, C; stage_rc(tid * 16 + i * 8192, R, C); const int Rb = Epi::PERM ? ((R & ~31) + perm32(R & 31)) : R; Rr[i] = R; Cc[i] = C; voffB[i] = (unsigned)(Rb * K + C) * 2u; }
    const size_t kstep = (size_t)(BK * 2);
    const size_t hstep = (size_t)HALF * K * 2;
    const unsigned ldsw = (unsigned)wid * 1024u;
    const int aoff = lds_byte(wr * 64 + fr, fq * 8), boff = lds_byte(wc * 32 + fr, fq * 8);
    const char* const Ab = S.a_base();
#define PG8_SA(b, h) (((b) * 2 + (h)) * HTB)
#define PG8_SB(b, h) ((4 + (b) * 2 + (h)) * HTB)
#define PG8_STAGE_B(bufoff, gbase) do { _Pragma("unroll") for (int _i = 0; _i < 2; ++_i) \
        __builtin_amdgcn_global_load_lds((const unsigned*)((const char*)(gbase) + voffB[_i]), (LAS unsigned*)(lds + (bufoff) + ldsw + _i * 8192), 16, 0, 0); } while (0)
#define PG8_STAGE_A(bufoff, o0, o1, kb) do { \
        __builtin_amdgcn_global_load_lds((const unsigned*)(Ab + (o0) + (kb)), (LAS unsigned*)(lds + (bufoff) + ldsw), 16, 0, 0); \
        __builtin_amdgcn_global_load_lds((const unsigned*)(Ab + (o1) + (kb)), (LAS unsigned*)(lds + (bufoff) + ldsw + 8192), 16, 0, 0); } while (0)
#define PG8_LDA(dst, b, h) do { _Pragma("unroll") for (int m = 0; m < 4; ++m) _Pragma("unroll") for (int k = 0; k < 2; ++k) dst[m][k] = *(const LAS bf16x8*)(lds + PG8_SA(b, h) + aoff + m * 2048 + k * 1024); } while (0)
#define PG8_LDB(dst, b, h) do { _Pragma("unroll") for (int n = 0; n < 2; ++n) _Pragma("unroll") for (int k = 0; k < 2; ++k) dst[n][k] = *(const LAS bf16x8*)(lds + PG8_SB(b, h) + boff + n * 2048 + k * 1024); } while (0)
#define PG8_MMA(ai, bj, At, Bt) do { __builtin_amdgcn_s_setprio(1); _Pragma("unroll") for (int m = 0; m < 4; ++m) _Pragma("unroll") for (int n = 0; n < 2; ++n) _Pragma("unroll") for (int k = 0; k < 2; ++k) \
        acc[ai][bj][m][n] = __builtin_amdgcn_mfma_f32_16x16x32_bf16(Bt[n][k], At[m][k], acc[ai][bj][m][n], 0, 0, 0); __builtin_amdgcn_s_setprio(0); } while (0)
#define PG8_WAIT_V(n) asm volatile("s_waitcnt vmcnt(" #n ")" ::: "memory")
#define PG8_WAIT_L(n) asm volatile("s_waitcnt lgkmcnt(" #n ")" ::: "memory")
#define PG8_BAR __builtin_amdgcn_s_barrier()
#define PG8_SCHED __builtin_amdgcn_sched_barrier(0)
    Unit cur, nxt; int ui = 0;
    if (!S.next(0, cur)) return;
    f32x4 acc[2][2][4][2];
#pragma unroll
    for (int a = 0; a < 2; ++a)
#pragma unroll
        for (int b = 0; b < 2; ++b)
#pragma unroll
            for (int m = 0; m < 4; ++m)
#pragma unroll
                for (int n = 0; n < 2; ++n) acc[a][b][m][n] = (f32x4){0.f, 0.f, 0.f, 0.f};
    bf16x8 At[4][2], B0[2][2], B1[2][2];
    unsigned oc[2][2], on[2][2];
    S.a_off(cur, Rr, Cc, oc);
    const char* cB = S.b_base(cur);
    PG8_STAGE_B(PG8_SB(0, 0), cB); PG8_STAGE_B(PG8_SB(0, 1), cB + hstep); PG8_STAGE_A(PG8_SA(0, 0), oc[0][0], oc[0][1], 0); PG8_STAGE_A(PG8_SA(0, 1), oc[1][0], oc[1][1], 0);
    if (wr == 1) PG8_BAR;
    PG8_WAIT_V(2); PG8_BAR;
    PG8_STAGE_B(PG8_SB(1, 0), cB + kstep); PG8_STAGE_A(PG8_SA(1, 0), oc[0][0], oc[0][1], kstep); PG8_STAGE_B(PG8_SB(1, 1), cB + hstep + kstep);
    PG8_WAIT_V(6); PG8_BAR;
    for (;;) {
        const bool has_next = S.next(ui + 1, nxt);
        const char* nB = cB;
        if (has_next) { S.a_off(nxt, Rr, Cc, on); nB = S.b_base(nxt); }
        else {
#pragma unroll
            for (int h = 0; h < 2; ++h)
#pragma unroll
                for (int i = 0; i < 2; ++i) on[h][i] = oc[h][i]; }
        for (int t = 0; t < nt; t += 2) {
            const bool last = (t == nt - 2);
            const size_t k1 = (size_t)(t + 1) * kstep;
            const size_t k2 = last ? 0 : (size_t)(t + 2) * kstep, k3 = k2 + kstep;
            const char* b2 = last ? nB : cB + (size_t)(t + 2) * kstep; const char* b3 = b2 + kstep;
            const unsigned a20 = last ? on[0][0] : oc[0][0], a21 = last ? on[0][1] : oc[0][1], a30 = last ? on[1][0] : oc[1][0], a31 = last ? on[1][1] : oc[1][1];
            PG8_LDB(B0, 0, 0); PG8_LDB(B1, 0, 1); PG8_SCHED; PG8_LDA(At, 0, 0); PG8_STAGE_A(PG8_SA(1, 1), oc[1][0], oc[1][1], k1);
            PG8_WAIT_V(8); PG8_WAIT_L(0); PG8_BAR; PG8_MMA(0, 0, At, B0); PG8_MMA(0, 1, At, B1); PG8_BAR; PG8_SCHED;
            PG8_LDA(At, 0, 1); PG8_STAGE_B(PG8_SB(0, 0), b2); PG8_STAGE_B(PG8_SB(0, 1), b2 + hstep); PG8_STAGE_A(PG8_SA(0, 0), a20, a21, k2);
            PG8_WAIT_V(8); PG8_WAIT_L(0); PG8_BAR; PG8_MMA(1, 0, At, B0); PG8_MMA(1, 1, At, B1); PG8_BAR; PG8_SCHED;
            PG8_LDB(B0, 1, 0); PG8_LDB(B1, 1, 1); PG8_SCHED; PG8_LDA(At, 1, 0); PG8_STAGE_A(PG8_SA(0, 1), a30, a31, k2);
            PG8_WAIT_V(8); PG8_WAIT_L(0); PG8_BAR; PG8_MMA(0, 0, At, B0); PG8_MMA(0, 1, At, B1); PG8_BAR; PG8_SCHED;
            PG8_LDA(At, 1, 1); PG8_STAGE_B(PG8_SB(1, 0), b3); PG8_STAGE_B(PG8_SB(1, 1), b3 + hstep); PG8_STAGE_A(PG8_SA(1, 0), a20, a21, k3);
            PG8_WAIT_V(8); PG8_WAIT_L(0); PG8_BAR; PG8_MMA(1, 0, At, B0); PG8_MMA(1, 1, At, B1); PG8_BAR; PG8_SCHED;
        }
        if constexpr (ALIGN_EPI) { if (wr == 0) PG8_BAR; }
        E(acc, cur, wr, wc, fr, fq);
        if (!has_next) break;
#pragma unroll
        for (int a = 0; a < 2; ++a)
#pragma unroll
            for (int b = 0; b < 2; ++b)
#pragma unroll
                for (int m = 0; m < 4; ++m)
#pragma unroll
                    for (int n = 0; n < 2; ++n) acc[a][b][m][n] = (f32x4){0.f, 0.f, 0.f, 0.f};
        cur = nxt; cB = nB; ++ui;
#pragma unroll
        for (int h = 0; h < 2; ++h)
#pragma unroll
            for (int i = 0; i < 2; ++i) oc[h][i] = on[h][i];
        if constexpr (ALIGN_EPI) { if (wr == 1) PG8_BAR; }
    }
    PG8_WAIT_V(0);
    if constexpr (!ALIGN_EPI) { if (wr == 0) PG8_BAR; }
    PG8_BAR;
#undef PG8_SA
#undef PG8_SB
#undef PG8_STAGE_A
#undef PG8_STAGE_B
#undef PG8_LDA
#undef PG8_LDB
#undef PG8_MMA
#undef PG8_WAIT_V
#undef PG8_WAIT_L
#undef PG8_BAR
#undef PG8_SCHED
}
}
constexpr int NWAVES = 8, NTHREADS = NWAVES * 64;
constexpr int RING_BYTES = 131072;
constexpr int LDS_BYTES = 163840;
constexpr int LDSCTL_OFF = 162816;
constexpr int CW_BAR = 4096;
typedef GAS unsigned gu32;
#define RLX_AGENT __ATOMIC_RELAXED, __HIP_MEMORY_SCOPE_AGENT
#define LDS_WAIT() asm volatile("s_waitcnt lgkmcnt(0)" ::: "memory")
#define VM_WAIT() asm volatile("s_waitcnt vmcnt(0)" ::: "memory")
__device__ __forceinline__ unsigned pk2(float lo, float hi) { return pg8::cvt_pk_bf16(lo, hi); }

#define XB_TMO      128
#define XB_XCNT(j)  (256  + 64 * (j))
#define XB_XSUB(j)  (1280 + 64 * (j))
#define XB_XGEN(j)  (2304 + 64 * (j))
#define XB_TOP      3328
#define XB_TOPGEN   3392
#define XCD_BAR_WORDS 3456
#define XB_SPIN_CAP (1u << 18)
__device__ __forceinline__ unsigned xb_ld(unsigned* p)              { return __hip_atomic_load(p, __ATOMIC_RELAXED, __HIP_MEMORY_SCOPE_AGENT); }
__device__ __forceinline__ unsigned xb_add(unsigned* p, unsigned v) { return __hip_atomic_fetch_add(p, v, __ATOMIC_RELAXED, __HIP_MEMORY_SCOPE_AGENT); }
__device__ __forceinline__ unsigned xb_xcc_id() { return (unsigned)__builtin_amdgcn_s_getreg((3 << 11) | 20) & 0xFu; }
#define XB_SPIN(cond, bar) do { unsigned _sp = 0; while (cond) { __builtin_amdgcn_s_sleep(1); \
    if ((++_sp & 255u) == 0u) { if (xb_ld(&(bar)[XB_TMO])) break; if (_sp > XB_SPIN_CAP) { atomicAdd(&(bar)[XB_TMO], 1u); break; } } } } while (0)
struct XcdBarrier { unsigned* bar; unsigned x; volatile LAS unsigned* st; };
__device__ __forceinline__ XcdBarrier xcd_barrier_post(unsigned* bar, volatile LAS unsigned* st) {
    XcdBarrier b; b.bar = bar; b.x = xb_xcc_id(); b.st = st;
    if (threadIdx.x == 0) (void)xb_add(&bar[XB_XCNT(b.x)], 1u);
    return b;
}
__device__ __forceinline__ void xcd_barrier_complete(unsigned* bar, unsigned x, unsigned& nloc, unsigned& nx) {
    const unsigned G = gridDim.x * gridDim.y * gridDim.z;
    unsigned sum, cnt, mine, sp = 0u;
    for (;;) {
        sum = 0u; cnt = 0u; mine = 0u;
#pragma unroll
        for (unsigned j = 0; j < 16; ++j) { const unsigned c = xb_ld(&bar[XB_XCNT(j)]); sum += c; cnt += (c > 0u) ? 1u : 0u; mine = (j == x) ? c : mine; }
        if (sum == G) break;
        __builtin_amdgcn_s_sleep(1);
        if ((++sp & 255u) == 0u) { if (xb_ld(&bar[XB_TMO])) break; if (sp > XB_SPIN_CAP) { atomicAdd(&bar[XB_TMO], 1u); break; } }
    }
    nloc = mine > 0u ? mine : 1u; nx = cnt > 0u ? cnt : 1u;
}
__device__ __forceinline__ void xcd_barrier(const XcdBarrier& b) {
    asm volatile("s_waitcnt vmcnt(0)" ::: "memory");
    __syncthreads();
    if (threadIdx.x == 0) {
        unsigned* bar = b.bar;
        __builtin_amdgcn_s_waitcnt(0);
        unsigned nloc = b.st[0], nx = b.st[1];
        if (nloc == 0u) { xcd_barrier_complete(bar, b.x, nloc, nx); b.st[0] = nloc; b.st[1] = nx; }
        const unsigned old = xb_add(&bar[XB_XSUB(b.x)], 1u);
        const unsigned gen = old / nloc;
        if (old + 1u == (gen + 1u) * nloc) {
            __builtin_amdgcn_fence(__ATOMIC_RELEASE, "agent");
            asm volatile("s_waitcnt vmcnt(0)" ::: "memory");
            const unsigned og = xb_add(&bar[XB_TOP], 1u);
            const unsigned tg = og / nx;
            if (og + 1u == (tg + 1u) * nx) xb_add(&bar[XB_TOPGEN], 1u);
            else XB_SPIN(xb_ld(&bar[XB_TOPGEN]) == tg, bar);
            __builtin_amdgcn_fence(__ATOMIC_ACQUIRE, "agent");
            xb_add(&bar[XB_XGEN(b.x)], 1u);
            asm volatile("s_waitcnt vmcnt(0)" ::: "memory");
        } else {
            XB_SPIN(xb_ld(&bar[XB_XGEN(b.x)]) == gen, bar);
            __builtin_amdgcn_fence(__ATOMIC_ACQUIRE, "agent");
            asm volatile("s_waitcnt vmcnt(0)" ::: "memory");
        }
    }
    __syncthreads();
}

struct Args { const float* in[16]; float* out; unsigned char* ws; int ph_lo, ph_hi; };

__device__ __forceinline__ void tr_item(const float* src, int ld, bf16* dst, int K, LAS float* scr, int lane) {
#pragma unroll 16
    for (int i = 0; i < 32; ++i) { const int kk = 2 * i + (lane >> 5); scr[kk * 33 + (lane & 31)] = __builtin_nontemporal_load(src + (size_t)kk * ld + (lane & 31)); }
    LDS_WAIT(); asm volatile("" ::: "memory");
    const int c = lane & 7;
#pragma unroll
    for (int j = 0; j < 4; ++j) { const int n = (lane >> 3) + 8 * j; const LAS float* s = scr + (8 * c) * 33 + n;
        u32x4 o; o.x = pk2(s[0 * 33], s[1 * 33]); o.y = pk2(s[2 * 33], s[3 * 33]); o.z = pk2(s[4 * 33], s[5 * 33]); o.w = pk2(s[6 * 33], s[7 * 33]);
        __builtin_nontemporal_store(o, (GAS u32x4*)(dst + (size_t)n * K + 8 * c)); }
    LDS_WAIT(); asm volatile("" ::: "memory");
}
__device__ __forceinline__ float wave_reduce16(const float (&p)[16], int lane) {
    float a[8], b[4], c[2], d;
    { const bool hi = lane & 32;
#pragma unroll
      for (int i = 0; i < 8; ++i) { const float mine = hi ? p[i + 8] : p[i], theirs = hi ? p[i] : p[i + 8]; a[i] = mine + __shfl_xor(theirs, 32); } }
    { const bool hi = lane & 16;
#pragma unroll
      for (int i = 0; i < 4; ++i) { const float mine = hi ? a[i + 4] : a[i], theirs = hi ? a[i] : a[i + 4]; b[i] = mine + __shfl_xor(theirs, 16); } }
    { const bool hi = lane & 8;
#pragma unroll
      for (int i = 0; i < 2; ++i) { const float mine = hi ? b[i + 2] : b[i], theirs = hi ? b[i] : b[i + 2]; c[i] = mine + __shfl_xor(theirs, 8); } }
    { const bool hi = lane & 4; const float mine = hi ? c[1] : c[0], theirs = hi ? c[0] : c[1]; d = mine + __shfl_xor(theirs, 4); }
    d += __shfl_xor(d, 1); d += __shfl_xor(d, 2);
    return d;
}
__device__ __forceinline__ void p0_prologue(const Args& a, LAS unsigned char* lds, int vcu, int G) {
    const int tid = threadIdx.x, lane = tid & 63, wave = __builtin_amdgcn_readfirstlane(tid >> 6);
    unsigned char* ws = a.ws;
    const float* w_in = a.in[2]; const float* w_out = a.in[6]; const float* ew1 = a.in[12]; const float* ew3 = a.in[13]; const float* ew2 = a.in[14];
    bf16* WinT = (bf16*)(ws + WS_WIN); bf16* WoutT = (bf16*)(ws + WS_WOUT); bf16* W13T = (bf16*)(ws + WS_W13); bf16* W2T = (bf16*)(ws + WS_W2);
    const int gw = vcu * NWAVES + wave, NGW = G * NWAVES;
    {
        LAS float* wl = (LAS float*)(lds + 67584);
        for (int k = tid; k < D; k += NTHREADS) { const int slot = ((k & 3) + 4 * (k >> 8)) * 64 + ((k >> 2) & 63); const float* src = w_in + (size_t)k * INC + GLR_SRC;
#pragma unroll
            for (int q = 0; q < 4; ++q) *(LAS f32x4*)(wl + slot * 20 + 4 * q) = *(const f32x4*)(src + 4 * q); }
    }
    __syncthreads();
    {
        const float* x = a.in[0]; const float* g1 = a.in[1]; bf16* N1 = (bf16*)(ws + WS_N1); float* GLR = (float*)(ws + WS_GLR);
        const LAS float* wl = (const LAS float*)(lds + 67584);
        f32x4 g[4];
#pragma unroll
        for (int j = 0; j < 4; ++j) g[j] = ((const f32x4*)g1)[lane + 64 * j];
        f32x4 nv[4];
        if (gw < M) {
#pragma unroll
            for (int j = 0; j < 4; ++j) nv[j] = __builtin_nontemporal_load((const f32x4*)(x + (size_t)gw * D) + lane + 64 * j); }
#pragma unroll 1
        for (int m = gw; m < M; m += NGW) {
            f32x4 v[4]; float s = 0.f;
#pragma unroll
            for (int j = 0; j < 4; ++j) v[j] = nv[j];
            if (m + NGW < M) {
#pragma unroll
                for (int j = 0; j < 4; ++j) nv[j] = __builtin_nontemporal_load((const f32x4*)(x + (size_t)(m + NGW) * D) + lane + 64 * j); }
#pragma unroll
            for (int j = 0; j < 4; ++j) { s += (v[j].x * v[j].x + v[j].y * v[j].y) + (v[j].z * v[j].z + v[j].w * v[j].w); }
            const float rstd = rsqrtf(wave_sum(s) * (1.f / D) + EPS);
            GAS u32x2* o8 = (GAS u32x2*)(N1 + (size_t)m * D) + lane;
            float p[16];
#pragma unroll
            for (int r = 0; r < 16; ++r) p[r] = 0.f;
#pragma unroll
            for (int j = 0; j < 4; ++j) { v[j] = v[j] * rstd * g[j]; u32x2 w; w.x = pk2(v[j].x, v[j].y); w.y = pk2(v[j].z, v[j].w); o8[64 * j] = w;
#pragma unroll
                for (int jj = 0; jj < 4; ++jj) { const LAS float* wr = wl + ((jj + 4 * j) * 64 + lane) * 20; const float xv = v[j][jj];
#pragma unroll
                    for (int q = 0; q < 4; ++q) { const f32x4 wv = *(const LAS f32x4*)(wr + 4 * q); p[4 * q] += xv * wv.x; p[4 * q + 1] += xv * wv.y; p[4 * q + 2] += xv * wv.z; p[4 * q + 3] += xv * wv.w; }
                    if (jj & 1) asm volatile("" ::: "memory"); } }
            const float tot = wave_reduce16(p, lane);
            if ((lane & 3) == 0) GLR[(size_t)m * 16 + ((lane >> 2) & 15)] = tot;
        }
    }
    { const float* wg = a.in[8]; const float* we = a.in[10]; bf16* WRT = (bf16*)(ws + WS_WRT);
      for (int idx = gw * 64 + lane; idx < D * 36; idx += NGW * 64) { const int k = idx / 36, col = idx % 36; const float wv = col < 4 ? wg[k * 4 + col] : we[k * 32 + col - 4];
          const bf16 hi = f2bf(wv), lo = f2bf(wv - bf2f(hi)); const int o = ((((k >> 5) * 2) * 36 + col) * 4 + ((k >> 3) & 3)) * 8 + (k & 7); WRT[o] = hi; WRT[o + 36 * 4 * 8] = lo; } }
    {
        LAS float* scr = (LAS float*)(lds + wave * 8448);
        constexpr int I_IN = 16 * 96, I_OUT = 16 * 32, NITEMS = I_IN + I_OUT;
        for (int it = gw; it < NITEMS; it += NGW) {
            int r = it;
            if (r < I_IN) { const int kb = r / 96, n0 = 32 * (r % 96); tr_item(w_in + (size_t)(64 * kb) * INC + (n0 < 1536 ? n0 : n0 + 16), INC, WinT + (size_t)n0 * D + 64 * kb, D, scr, lane); continue; } r -= I_IN;
            { const int kb = r / 32, n0 = 32 * (r % 32); tr_item(w_out + (size_t)(64 * kb) * D + n0, D, WoutT + (size_t)n0 * D + 64 * kb, D, scr, lane); }
        }
    }
}
__device__ __forceinline__ void p0_expert_items(const Args& a, LAS unsigned char* lds, int first, int stride, int end) {
    const int lane = threadIdx.x & 63, wave = __builtin_amdgcn_readfirstlane(threadIdx.x >> 6);
    const float* ew1 = a.in[12]; const float* ew3 = a.in[13]; const float* ew2 = a.in[14];
    bf16* W13T = (bf16*)(a.ws + WS_W13); bf16* W2T = (bf16*)(a.ws + WS_W2);
    LAS float* scr = (LAS float*)(lds + wave * 8448);
    constexpr int I_13 = NE * 16 * 32;
    for (int it = first; it < end; it += stride) {
        int r = it;
        if (r < I_13) { const int e = r / 512, q = r % 512, kb = q / 32, n0 = 32 * (q % 32); const float* w = ((n0 >> 7) & 1) ? ew3 : ew1;
            tr_item(w + ((size_t)e * D + 64 * kb) * FF + 128 * (n0 >> 8) + (n0 & 127), FF, W13T + (size_t)e * D * D + (size_t)n0 * D + 64 * kb, D, scr, lane); continue; } r -= I_13;
        { const int e = r / 256, q = r % 256, kb = q / 32, n0 = 32 * (q % 32);
            tr_item(ew2 + ((size_t)e * FF + 64 * kb) * D + n0, D, W2T + (size_t)e * D * FF + (size_t)n0 * FF + 64 * kb, FF, scr, lane); }
    }
}
__device__ __forceinline__ void p8_final(const Args& a, int vcu, int G, float* dst) {
    const int tid = threadIdx.x, lane = tid & 63, wave = __builtin_amdgcn_readfirstlane(tid >> 6);
    const int gw = vcu * NWAVES + wave, NGW = G * NWAVES;
    const bf16* Y = (const bf16*)(a.ws + WS_Y); float* out = a.out; const float* gf = a.in[15];
    f32x4 g[4];
#pragma unroll
    for (int j = 0; j < 4; ++j) g[j] = ((const f32x4*)gf)[lane + 64 * j];
#pragma unroll 1
    for (int m = gw; m < M; m += NGW) {
        const f32x4* hr = (const f32x4*)(a.in[0] + (size_t)m * D) + lane; const u32x2* tr = (const u32x2*)((const bf16*)out + (size_t)m * (2 * D)) + lane;
        const u32x2* y0 = (const u32x2*)(Y + (size_t)(2 * m) * D) + lane; const u32x2* y1 = y0 + D / 4;
        f32x4 v[4]; float s = 0.f;
#pragma unroll
        for (int j = 0; j < 4; ++j) { v[j] = __builtin_nontemporal_load(hr + 64 * j); const u32x2 p = __builtin_nontemporal_load(y0 + 64 * j), q = __builtin_nontemporal_load(y1 + 64 * j), tv = __builtin_nontemporal_load(tr + 64 * j);
            v[j].x += __uint_as_float(tv.x << 16); v[j].y += __uint_as_float(tv.x & 0xffff0000u); v[j].z += __uint_as_float(tv.y << 16); v[j].w += __uint_as_float(tv.y & 0xffff0000u);
            v[j].x += __uint_as_float(p.x << 16) + __uint_as_float(q.x << 16); v[j].y += __uint_as_float(p.x & 0xffff0000u) + __uint_as_float(q.x & 0xffff0000u);
            v[j].z += __uint_as_float(p.y << 16) + __uint_as_float(q.y << 16); v[j].w += __uint_as_float(p.y & 0xffff0000u) + __uint_as_float(q.y & 0xffff0000u);
            s += (v[j].x * v[j].x + v[j].y * v[j].y) + (v[j].z * v[j].z + v[j].w * v[j].w); }
        const float rstd = rsqrtf(wave_sum(s) * (1.f / D) + EPS);
#pragma unroll
        for (int j = 0; j < 4; ++j) __builtin_nontemporal_store(v[j] * rstd * g[j], (f32x4*)(dst + (size_t)m * D) + lane + 64 * j);
    }
}

constexpr int LDS_PB = LDSCTL_OFF + 128;
constexpr int LDS_CNT = LDSCTL_OFF + 384;
constexpr int LDS_LCNT = 147456, LDS_LBASE = 147584, LDS_REC = 147712, REC_ITERS = 4;
constexpr int LDS_REX = 149760, REX_BYTES = 3200;
constexpr int CNT_STRIDE = 64;
__device__ __forceinline__ void p5_router(const Args& a, LAS unsigned char* lds, int vcu, int G) {
    const int tid = threadIdx.x, lane = tid & 63, wave = __builtin_amdgcn_readfirstlane(tid >> 6), fr = lane & 15, fq = lane >> 4, pr = wave >> 1, half = wave & 1;
    unsigned char* ws = a.ws;
    const float* x = a.in[0]; const bf16* tmix = (const bf16*)a.out; const float* g2 = a.in[7];
    const float* bgp = a.in[9]; const float* be = a.in[11];
    bf16* N2 = (bf16*)(ws + WS_N2); float* RSTD = (float*)(ws + WS_RSTD); Route* ROUTE = (Route*)(ws + WS_ROUTE); int* LIST = (int*)(ws + WS_LIST);
    unsigned* cnt = (unsigned*)(ws + WS_CTL) + CW_CNT;
    { const u32x4* src = (const u32x4*)(ws + WS_WRT); LAS u32x4* dst = (LAS u32x4*)lds;
      for (int i = tid; i < 147456 / 16; i += NTHREADS) dst[i] = src[i]; }
    if (tid < NE) ((LAS unsigned*)(lds + LDS_LCNT))[tid] = 0u;
    __syncthreads();
    LAS unsigned* lcnt = (LAS unsigned*)(lds + LDS_LCNT); LAS unsigned* lbase = (LAS unsigned*)(lds + LDS_LBASE); LAS unsigned* rec = (LAS unsigned*)(lds + LDS_REC) + pr * (REC_ITERS * 32);
    LAS unsigned char* ex = lds + LDS_REX + pr * REX_BYTES; LAS float* lg = (LAS float*)ex;
    const int niter = (M / 16 + G * 4 - 1) / (G * 4);
#pragma unroll 1
    for (int it = 0; it < niter; ++it) {
        const int tile = vcu * 4 + pr + it * G * 4; const bool live = tile < M / 16;
        f32x4 acc[3]; acc[0] = (f32x4){0.f, 0.f, 0.f, 0.f}; acc[1] = acc[0]; acc[2] = acc[0]; float ssq = 0.f;
        if (live) {
            const int row = tile * 16 + fr;
            const float* xr = x + (size_t)row * D + 8 * fq + 512 * half; const bf16* tr = tmix + (size_t)row * (2 * D) + 8 * fq + 512 * half; bf16* nr = N2 + (size_t)row * D + 8 * fq + 512 * half; const float* gr = g2 + 8 * fq + 512 * half;
            const LAS unsigned char* tb = lds + (fr * 4 + fq) * 16 + half * 16 * (2 * 36 * 64);
            const int o2 = ((32 + (fr & 3)) * 4 + fq) * 16 - (fr * 4 + fq) * 16;
#pragma unroll 1
            for (int sb = 0; sb < 16; sb += 4) {
                f32x4 xa[4], xb[4], ga[4], gb[4]; u32x4 ta[4];
#pragma unroll
                for (int q = 0; q < 4; ++q) { const int s = sb + q;
                    xa[q] = __builtin_nontemporal_load((const f32x4*)(xr + 32 * s)); xb[q] = __builtin_nontemporal_load((const f32x4*)(xr + 32 * s + 4));
                    ta[q] = __builtin_nontemporal_load((const u32x4*)(tr + 32 * s)); ga[q] = *(const f32x4*)(gr + 32 * s); gb[q] = *(const f32x4*)(gr + 32 * s + 4); }
#pragma unroll
                for (int q = 0; q < 4; ++q) { const int s = sb + q;
                    const f32x4 x0 = xa[q], x1 = xb[q], g0 = ga[q], g1 = gb[q]; const u32x4 tv = ta[q];
                    float hv[8] = {x0.x + __uint_as_float(tv.x << 16), x0.y + __uint_as_float(tv.x & 0xffff0000u), x0.z + __uint_as_float(tv.y << 16), x0.w + __uint_as_float(tv.y & 0xffff0000u),
                                   x1.x + __uint_as_float(tv.z << 16), x1.y + __uint_as_float(tv.z & 0xffff0000u), x1.z + __uint_as_float(tv.w << 16), x1.w + __uint_as_float(tv.w & 0xffff0000u)};
                    const float gg[8] = {g0.x, g0.y, g0.z, g0.w, g1.x, g1.y, g1.z, g1.w};
#pragma unroll
                    for (int j = 0; j < 8; ++j) { ssq += hv[j] * hv[j]; hv[j] *= gg[j]; }
                    u32x4 hi; hi.x = pg8::cvt_pk_bf16(hv[0], hv[1]); hi.y = pg8::cvt_pk_bf16(hv[2], hv[3]); hi.z = pg8::cvt_pk_bf16(hv[4], hv[5]); hi.w = pg8::cvt_pk_bf16(hv[6], hv[7]);
                    *(u32x4*)(nr + 32 * s) = hi;
                    u32x4 lo; lo.x = pg8::cvt_pk_bf16(hv[0] - __uint_as_float(hi.x << 16), hv[1] - __uint_as_float(hi.x & 0xffff0000u)); lo.y = pg8::cvt_pk_bf16(hv[2] - __uint_as_float(hi.y << 16), hv[3] - __uint_as_float(hi.y & 0xffff0000u));
                    lo.z = pg8::cvt_pk_bf16(hv[4] - __uint_as_float(hi.z << 16), hv[5] - __uint_as_float(hi.z & 0xffff0000u)); lo.w = pg8::cvt_pk_bf16(hv[6] - __uint_as_float(hi.w << 16), hv[7] - __uint_as_float(hi.w & 0xffff0000u));
                    const bf16x8 ah = __builtin_bit_cast(bf16x8, hi), al = __builtin_bit_cast(bf16x8, lo);
                    const LAS unsigned char* th = tb + s * (2 * 36 * 64); const LAS unsigned char* tl = th + 36 * 64;
#pragma unroll
                    for (int ct = 0; ct < 3; ++ct) { const int o = ct < 2 ? ct * 1024 : o2;
                        const bf16x8 bh = *(const LAS bf16x8*)(th + o), bl = *(const LAS bf16x8*)(tl + o);
                        acc[ct] = __builtin_amdgcn_mfma_f32_16x16x32_bf16(ah, bh, acc[ct], 0, 0, 0);
                        acc[ct] = __builtin_amdgcn_mfma_f32_16x16x32_bf16(ah, bl, acc[ct], 0, 0, 0);
                        acc[ct] = __builtin_amdgcn_mfma_f32_16x16x32_bf16(al, bh, acc[ct], 0, 0, 0); }
                }
            }
            ssq += __shfl_xor(ssq, 16); ssq += __shfl_xor(ssq, 32);
            if (half) {
#pragma unroll
                for (int ct = 0; ct < 3; ++ct) *(LAS f32x4*)(ex + (ct * 64 + lane) * 16) = acc[ct];
                if (lane < 16) *(LAS float*)(ex + 3072 + lane * 4) = ssq; }
        }
        __syncthreads();
        if (live && !half) {
#pragma unroll
            for (int ct = 0; ct < 3; ++ct) acc[ct] += *(const LAS f32x4*)(ex + (ct * 64 + lane) * 16);
            ssq += *(const LAS float*)(ex + 3072 + fr * 4);
            const float rstd = rsqrtf(ssq * (1.f / D) + EPS);
            LDS_WAIT(); asm volatile("" ::: "memory");
#pragma unroll
            for (int ct = 0; ct < 3; ++ct)
#pragma unroll
                for (int r = 0; r < 4; ++r) { const int col = 16 * ct + fr; if (col < 36) lg[(4 * fq + r) * 36 + col] = acc[ct][r]; }
            LDS_WAIT(); asm volatile("" ::: "memory");
            if (lane < 16) {
                const LAS float* l = lg + 36 * lane; const int rw = tile * 16 + lane;
                int gi = 0; float gmax = l[0] * rstd + bgp[0];
                for (int c = 1; c < 4; ++c) { const float v = l[c] * rstd + bgp[c]; if (v > gmax) { gmax = v; gi = c; } }
                float den = 0.f; for (int c = 0; c < 4; ++c) den += __expf(l[c] * rstd + bgp[c] - gmax);
                const float gprob = 1.f / den;
                float b0 = -INFINITY, b1 = -INFINITY; int i0 = 0, i1 = 0;
                for (int c = 0; c < 8; ++c) { const float v = l[4 + gi * 8 + c] * rstd + be[gi * 8 + c]; if (v > b0) { b1 = b0; i1 = i0; b0 = v; i0 = c; } else if (v > b1) { b1 = v; i1 = c; } }
                const float e1x = __expf(b1 - b0); const float w0 = gprob / (1.f + e1x), w1 = gprob * e1x / (1.f + e1x);
                Route r; r.e0 = gi * 8 + i0; r.e1 = gi * 8 + i1; r.w0 = w0; r.w1 = w1; ROUTE[rw] = r; RSTD[rw] = rstd;
                const unsigned q0 = __hip_atomic_fetch_add(lcnt + r.e0, 1u, __ATOMIC_RELAXED, __HIP_MEMORY_SCOPE_WORKGROUP), q1 = __hip_atomic_fetch_add(lcnt + r.e1, 1u, __ATOMIC_RELAXED, __HIP_MEMORY_SCOPE_WORKGROUP);
                if (it < REC_ITERS) { rec[it * 32 + lane * 2] = ((unsigned)r.e0 << 16) | q0; rec[it * 32 + lane * 2 + 1] = ((unsigned)r.e1 << 16) | q1; }
            }
        }
        __syncthreads();
    }
    if (tid < NE) lbase[tid] = atomicAdd(&cnt[tid * CNT_STRIDE], lcnt[tid]);
    __syncthreads();
    if (!half && lane < 16) {
#pragma unroll 1
        for (int it = 0; it < niter && it < REC_ITERS; ++it) { const int tile = vcu * 4 + pr + it * G * 4; if (tile >= M / 16) break; const int rw = tile * 16 + lane;
            const Route rtw = ROUTE[rw]; const float rsw = RSTD[rw];
#pragma unroll
            for (int j = 0; j < 2; ++j) { const unsigned rc = rec[it * 32 + lane * 2 + j]; const int e = (int)(rc >> 16), idx = e * LIST_CAP + (int)(lbase[e] + (rc & 0xffffu));
                LIST[idx] = rw * 2 + j; ((float*)(ws + WS_LRS))[idx] = rsw; ((float*)(ws + WS_LGW))[idx] = j ? rtw.w1 : rtw.w0; } } }
}
namespace pg8 {
struct MoeOrder {
    const LAS int* pb; const LAS int* pba; const LAS int* cn; const int* list; const char* A; const char* W; int K, nN, G, c, gather; size_t wstride;
    __device__ __forceinline__ bool next(int i, Unit& u) const {
        const int L = i * G + c, NB = pb[NE]; if (L >= NB * nN) return false;
        const int rb = L / nN; u.pn = L % nN;
        int e = 0;
#pragma unroll
        for (int s = 16; s >= 1; s >>= 1) if (pb[e + s] <= rb) e += s;
        u.e = e; u.pm = rb - pb[e]; const int left = cn[e] - 256 * u.pm; u.nrows = left < 256 ? left : 256; return true;
    }
    __device__ __forceinline__ void a_off(const Unit& u, const int (&R)[2], const int (&C)[2], unsigned (&off)[2][2]) const {
#pragma unroll
        for (int h = 0; h < 2; ++h)
#pragma unroll
            for (int i = 0; i < 2; ++i) { const int r = h * HALF + R[i];
                if (gather) { const int tok = r < u.nrows ? (list[u.e * LIST_CAP + 256 * u.pm + r] >> 1) : 0; off[h][i] = (unsigned)((tok * K + C[i]) * 2); }
                else off[h][i] = (unsigned)(((256 * (pba[u.e] + u.pm) + r) * K + C[i]) * 2); }
    }
    __device__ __forceinline__ const char* a_base() const { return A; }
    __device__ __forceinline__ const char* b_base(const Unit& u) const { return W + (size_t)u.e * wstride + (size_t)u.pn * BM * K * 2; }
};
struct EpiMoeUp {
    static constexpr bool PERM = true;
    bf16* HID; const float* lrs; const float* lgw; const LAS int* pba;
    __device__ __forceinline__ void operator()(const f32x4 (&acc)[2][2][4][2], const Unit& u, int wr, int wc, int fr, int fq) const {
        const int prow0 = 256 * (pba[u.e] + u.pm);
#pragma unroll
        for (int ai = 0; ai < 2; ++ai)
#pragma unroll
            for (int m = 0; m < 4; ++m) { const int r = ai * HALF + wr * 64 + m * 16 + fr;
                const int li = u.e * LIST_CAP + 256 * u.pm + (r < u.nrows ? r : 0); const float rs = lrs[li], gw = lgw[li];
                float hv[8];
#pragma unroll
                for (int n = 0; n < 2; ++n)
#pragma unroll
                    for (int q = 0; q < 4; ++q) { const float x = acc[ai][0][m][n][q] * rs, y = acc[ai][1][m][n][q] * rs; hv[4 * n + q] = x * __builtin_amdgcn_rcpf(1.f + __expf(-x)) * (y * gw); }
                u32x4 w; w.x = cvt_pk_bf16(hv[0], hv[1]); w.y = cvt_pk_bf16(hv[2], hv[3]); w.z = cvt_pk_bf16(hv[4], hv[5]); w.w = cvt_pk_bf16(hv[6], hv[7]);
                *(u32x4*)(HID + (size_t)(prow0 + r) * FF + 128 * u.pn + 32 * wc + 8 * fq) = w; }
    }
};
struct EpiMoeDown {
    static constexpr bool PERM = true;
    bf16* Y; const int* list;
    __device__ __forceinline__ void operator()(const f32x4 (&acc)[2][2][4][2], const Unit& u, int wr, int wc, int fr, int fq) const {
#pragma unroll
        for (int ai = 0; ai < 2; ++ai)
#pragma unroll
            for (int m = 0; m < 4; ++m) { const int r = ai * HALF + wr * 64 + m * 16 + fr;
                if (r < u.nrows) { const int slot = list[u.e * LIST_CAP + 256 * u.pm + r];
                    bf16* rowp = Y + (size_t)slot * D + u.pn * BM + wc * 32 + 8 * fq;
#pragma unroll
                    for (int bj = 0; bj < 2; ++bj) { const f32x4 v0 = acc[ai][bj][m][0], v1 = acc[ai][bj][m][1];
                        u32x4 o; o.x = cvt_pk_bf16(v0[0], v0[1]); o.y = cvt_pk_bf16(v0[2], v0[3]); o.z = cvt_pk_bf16(v1[0], v1[1]); o.w = cvt_pk_bf16(v1[2], v1[3]);
                        pg8::st16_wt(rowp + bj * HALF, o); } } }
    }
};
}
constexpr int LDS_PBA = LDSCTL_OFF + 512, LDS_PTR = LDSCTL_OFF + 656;
__device__ __forceinline__ void moe_prefix(const Args& a, LAS unsigned char* lds, int G) {
    const unsigned* cnt = (const unsigned*)(a.ws + WS_CTL) + CW_CNT;
    LAS int* pb = (LAS int*)(lds + LDS_PB); LAS int* cn = (LAS int*)(lds + LDS_CNT); LAS int* pba = (LAS int*)(lds + LDS_PBA); LAS int* ptr = (LAS int*)(lds + LDS_PTR);
    __syncthreads();
    if (threadIdx.x < 64) {
        const int lane = threadIdx.x, e = lane & 31; const int c = (int)cnt[e * CNT_STRIDE];
        const int nf = c >> 8, tail = c & 255;
        int nbf = nf;
#pragma unroll
        for (int o = 1; o < 32; o <<= 1) nbf += __shfl_xor(nbf, o);
        const int cap = ((4 * nbf + G - 1) / G) * G / 4, x = cap - nbf;
        int rank = 0;
#pragma unroll 1
        for (int j = 0; j < 32; ++j) { const int tj = __shfl(tail, j); rank += (tj > tail || (tj == tail && j < e)) ? 1 : 0; }
        const int istile = (tail > 0 && rank < x) ? 1 : 0;
        const int nbt = nf + istile, nba = (c + 255) >> 8, ntr = (!istile && tail > 0) ? ((tail + 31) >> 5) : 0;
        int s1 = nbt, s2 = nba, s3 = ntr;
#pragma unroll
        for (int o = 1; o < 32; o <<= 1) { const int t1 = __shfl_up(s1, o), t2 = __shfl_up(s2, o), t3 = __shfl_up(s3, o); if (e >= o) { s1 += t1; s2 += t2; s3 += t3; } }
        if (lane < 32) { cn[e] = c; pb[e + 1] = s1; pba[e + 1] = s2; ptr[e + 1] = s3; if (e == 0) { pb[0] = 0; pba[0] = 0; ptr[0] = 0; } }
    }
    __syncthreads();
}
template <int NJ> __device__ __forceinline__ void wave_mm_tail(const bf16* a0, const bf16* a1, const bf16* b0, size_t bstride16, int K, f32x4 (&acc)[2][NJ]) {
    const int fq = (threadIdx.x & 63) >> 4;
#pragma unroll 2
    for (int k0 = 0; k0 < K; k0 += 32) {
        const bf16x8 fa0 = *(const bf16x8*)(a0 + k0 + 8 * fq), fa1 = *(const bf16x8*)(a1 + k0 + 8 * fq);
#pragma unroll
        for (int j = 0; j < NJ; ++j) { const bf16x8 fb = *(const bf16x8*)(b0 + j * bstride16 + k0 + 8 * fq);
            acc[0][j] = __builtin_amdgcn_mfma_f32_16x16x32_bf16(fa0, fb, acc[0][j], 0, 0, 0); acc[1][j] = __builtin_amdgcn_mfma_f32_16x16x32_bf16(fa1, fb, acc[1][j], 0, 0, 0); }
    }
}
template <bool UP> __device__ __forceinline__ void moe_tail_tasks(const Args& a, LAS unsigned char* lds, int c_, int G) {
    const LAS int* pb = (const LAS int*)(lds + LDS_PB); const LAS int* cn = (const LAS int*)(lds + LDS_CNT); const LAS int* pba = (const LAS int*)(lds + LDS_PBA); const LAS int* ptr = (const LAS int*)(lds + LDS_PTR);
    const int tid = threadIdx.x, lane = tid & 63, wave = __builtin_amdgcn_readfirstlane(tid >> 6), fr = lane & 15;
    constexpr int NJ = UP ? 4 : 8, CW = 16 * NJ, NCT = (UP ? FF : D) / CW, K = UP ? D : FF, KW = K / NWAVES, NTILE = (UP ? 2 : 1) * 2 * NJ;
    const int NT = ptr[NE] * NCT;
    const int* list = (const int*)(a.ws + WS_LIST); const bf16* N2 = (const bf16*)(a.ws + WS_N2); bf16* HID = (bf16*)(a.ws + WS_HID);
    LAS f32x4* P = (LAS f32x4*)lds;
#pragma unroll 1
    for (int tt = c_; tt < NT; tt += G) {
        const int rt = tt / NCT, ct = tt % NCT;
        int e = 0;
#pragma unroll
        for (int s = 16; s >= 1; s >>= 1) if (ptr[e + s] <= rt) e += s;
        const int c = cn[e], r0 = 256 * (pb[e + 1] - pb[e]) + 32 * (rt - ptr[e]), prow = 256 * pba[e];
        const int p0 = r0 + fr, p1 = r0 + 16 + fr, k0 = wave * KW;
        if (UP) {
            const int t0 = p0 < c ? (list[e * LIST_CAP + p0] >> 1) : 0, t1 = p1 < c ? (list[e * LIST_CAP + p1] >> 1) : 0;
            const int j0 = ct * CW + fr, ra = 256 * (j0 >> 7) + (j0 & 127);
            const bf16* W = (const bf16*)(a.ws + WS_W13) + (size_t)e * D * D + k0;
            f32x4 accA[2][NJ] = {}, accB[2][NJ] = {};
            wave_mm_tail<NJ>(N2 + (size_t)t0 * D + k0, N2 + (size_t)t1 * D + k0, W + (size_t)ra * D, (size_t)16 * D, KW, accA);
            wave_mm_tail<NJ>(N2 + (size_t)t0 * D + k0, N2 + (size_t)t1 * D + k0, W + (size_t)(ra + 128) * D, (size_t)16 * D, KW, accB);
#pragma unroll
            for (int i = 0; i < 2; ++i)
#pragma unroll
                for (int j = 0; j < NJ; ++j) { P[(wave * NTILE + i * NJ + j) * 64 + lane] = accA[i][j]; P[(wave * NTILE + 2 * NJ + i * NJ + j) * 64 + lane] = accB[i][j]; }
        } else {
            const int q0 = p0 < c ? p0 : 0, q1 = p1 < c ? p1 : 0, c0 = ct * CW;
            const bf16* W = (const bf16*)(a.ws + WS_W2) + (size_t)e * D * FF + k0;
            f32x4 acc[2][NJ] = {};
            wave_mm_tail<NJ>(HID + (size_t)(prow + q0) * FF + k0, HID + (size_t)(prow + q1) * FF + k0, W + (size_t)(c0 + fr) * FF, (size_t)16 * FF, KW, acc);
#pragma unroll
            for (int i = 0; i < 2; ++i)
#pragma unroll
                for (int j = 0; j < NJ; ++j) P[(wave * NTILE + i * NJ + j) * 64 + lane] = acc[i][j];
        }
        __syncthreads();
        {
            const int ln = tid & 63, g = tid >> 6, frr = ln & 15, fqq = ln >> 4;
#pragma unroll
            for (int q = 0; q < (UP ? 1 : 2); ++q) { const int ij = UP ? g : 2 * g + q, i = ij / NJ, j = ij % NJ;
                f32x4 sa = (f32x4){0.f, 0.f, 0.f, 0.f}, sb = sa;
#pragma unroll
                for (int w = 0; w < NWAVES; ++w) { sa += P[(w * NTILE + ij) * 64 + ln]; if (UP) sb += P[(w * NTILE + 2 * NJ + ij) * 64 + ln]; }
#pragma unroll
                for (int r = 0; r < 4; ++r) { const int pos = r0 + 16 * i + 4 * fqq + r;
                    if (pos < c) {
                        const int slot = list[e * LIST_CAP + pos];
                        if (UP) { const float rs = ((const float*)(a.ws + WS_LRS))[e * LIST_CAP + pos], w = ((const float*)(a.ws + WS_LGW))[e * LIST_CAP + pos]; const float x = sa[r] * rs, y = sb[r] * rs;
                            HID[(size_t)(prow + pos) * FF + ct * CW + 16 * j + frr] = f2bf(x * __builtin_amdgcn_rcpf(1.f + __expf(-x)) * (y * w)); }
                        else ((bf16*)(a.ws + WS_Y))[(size_t)slot * D + ct * CW + 16 * j + frr] = f2bf(sa[r]); } } }
        }
        __syncthreads();
    }
}
typedef short v4i16_t __attribute__((ext_vector_type(4)));
typedef float f32x16 __attribute__((ext_vector_type(16)));
template <int RB> __device__ __forceinline__ int img_off(int row, int chunk) { return row * RB + ((chunk ^ (row & 7)) << 4); }
template <int RB> __device__ __forceinline__ bf16x8 frag_row(const LAS unsigned char* img, int row0, int k0, int lane) {
    return *(const LAS bf16x8*)(img + img_off<RB>(row0 + (lane & 31), (k0 >> 3) + (lane >> 5)));
}
template <int RB, bool PERMK> __device__ __forceinline__ bf16x8 frag_col(const LAS unsigned char* img, int k0, int n0, int lane) {
    const int h = lane >> 5, ch = (lane >> 4) & 1, q = (lane & 15) >> 2, p = lane & 3;
    const int ra = k0 + (PERMK ? 4 * h : 8 * h) + q, rb = ra + (PERMK ? 8 : 4);
    const int chunk = (n0 >> 3) + 2 * ch + (p >> 1), sub = (p & 1) * 8;
    const v4i16_t lo = __builtin_amdgcn_ds_read_tr16_b64_v4i16((LAS v4i16_t*)(img + img_off<RB>(ra, chunk) + sub));
    const v4i16_t hi = __builtin_amdgcn_ds_read_tr16_b64_v4i16((LAS v4i16_t*)(img + img_off<RB>(rb, chunk) + sub));
    return (bf16x8){lo[0], lo[1], lo[2], lo[3], hi[0], hi[1], hi[2], hi[3]};
}
__device__ __forceinline__ int crow(int r, int h) { return (r & 3) + 8 * (r >> 2) + 4 * h; }
__device__ __forceinline__ bf16x8 pack8(const f32x16& x, int s) {
    u32x4 w; w.x = pg8::cvt_pk_bf16(x[8 * s], x[8 * s + 1]); w.y = pg8::cvt_pk_bf16(x[8 * s + 2], x[8 * s + 3]); w.z = pg8::cvt_pk_bf16(x[8 * s + 4], x[8 * s + 5]); w.w = pg8::cvt_pk_bf16(x[8 * s + 6], x[8 * s + 7]);
    return __builtin_bit_cast(bf16x8, w);
}

constexpr int ATT_UNITS = BATCH * 8 * 3 * 32;
constexpr int ATT_LK = 0, ATT_LV = 49152, ATT_STG = 98304, ATT_WS = 131072;
constexpr float ATT_C = 0.125f * 1.4426950408889634f;
struct AttU { int b, head, br, d, r, i0; };
__device__ __forceinline__ AttU attn_decode(int u) { AttU a; const int x = u & 31; a.br = (u >> 5) % 3; const int bh = (u >> 5) / 3; a.b = bh >> 3; a.head = bh & 7;
    a.d = a.br == 0 ? 1 : (a.br == 1 ? 4 : 16); const int nblk = 32 / a.d; a.r = x / nblk; a.i0 = (x % nblk) * 256; return a; }
template <int WHICH> __device__ __forceinline__ void attn_fetch(const AttU& a, const bf16* proj, u32x4 (&kv)[6]) {
    const int tid = threadIdx.x; const bf16* pb = proj + (size_t)a.b * T * NPROJ + a.head * 64 + (WHICH ? C_AV : C_AK);
#pragma unroll
    for (int it = 0; it < 6; ++it) { const int c = tid + NTHREADS * it, row = c >> 3, ch = c & 7, ki = a.i0 - 128 + row, kc = ki < 0 ? 0 : ki;
        kv[it] = *(const u32x4*)(pb + (size_t)(kc * a.d + a.r) * NPROJ + ch * 8); }
}
template <int WHICH> __device__ __forceinline__ void attn_put(const u32x4 (&kv)[6], LAS unsigned char* lds) {
    const int tid = threadIdx.x;
#pragma unroll
    for (int it = 0; it < 6; ++it) { const int c = tid + NTHREADS * it, row = c >> 3, ch = c & 7; *(LAS u32x4*)(lds + (WHICH ? ATT_LV : ATT_LK) + img_off<128>(row, ch)) = kv[it]; }
}
__device__ __forceinline__ void attn_unit(const AttU& a, const AttU& an, u32x4 (&kk)[6], u32x4 (&vv)[6], const bf16* proj, bf16* OBR, float* ML, LAS unsigned char* lds) {
    const int tid = threadIdx.x, lane = tid & 63, w = __builtin_amdgcn_readfirstlane(tid >> 6), r32 = lane & 31, h = lane >> 5;
    const int d = a.d, r = a.r, i0 = a.i0, b = a.b, head = a.head, br = a.br;
    const bf16* pb = proj + (size_t)b * T * NPROJ + head * 64;
    bf16x8 qf[4];
    { const bf16* qp = pb + (size_t)((i0 + 32 * w + r32) * d + r) * NPROJ + C_AQ + 8 * h;
#pragma unroll
      for (int s = 0; s < 4; ++s) qf[s] = *(const bf16x8*)(qp + 16 * s); }
    attn_put<0>(kk, lds); attn_put<1>(vv, lds);
    __syncthreads();
    attn_fetch<0>(an, proj, kk);
    f32x16 S[5];
    { bf16x8 kf[2][4];
#pragma unroll
      for (int s = 0; s < 4; ++s) kf[0][s] = frag_row<128>(lds + ATT_LK, 32 * w, 16 * s, lane);
#pragma unroll
      for (int t = 0; t < 5; ++t) {
          if (t < 4) {
#pragma unroll
              for (int s = 0; s < 4; ++s) kf[(t + 1) & 1][s] = frag_row<128>(lds + ATT_LK, 32 * w + 32 * (t + 1), 16 * s, lane); }
          __builtin_amdgcn_sched_barrier(0);
          S[t] = (f32x16){};
#pragma unroll
          for (int s = 0; s < 4; ++s) S[t] = __builtin_amdgcn_mfma_f32_32x32x16_bf16(kf[t & 1][s], qf[s], S[t], 0, 0, 0);
          __builtin_amdgcn_sched_barrier(0); } }
    const int kbase = i0 + 32 * w - 128;
#pragma unroll
    for (int rr = 0; rr < 16; ++rr) { const int kr = crow(rr, h); S[0][rr] = (kr >= r32) ? S[0][rr] : -INFINITY; S[4][rr] = (kr <= r32) ? S[4][rr] : -INFINITY; }
    if (kbase < 0) {
#pragma unroll
        for (int t = 0; t < 5; ++t)
#pragma unroll
            for (int rr = 0; rr < 16; ++rr) S[t][rr] = (kbase + 32 * t + crow(rr, h)) >= 0 ? S[t][rr] : -INFINITY; }
    float mx = -INFINITY;
#pragma unroll
    for (int t = 0; t < 5; ++t)
#pragma unroll
        for (int rr = 0; rr < 16; ++rr) mx = fmaxf(mx, S[t][rr]);
    mx = fmaxf(mx, __shfl_xor(mx, 32)) * ATT_C;
    float ls = 0.f;
#pragma unroll
    for (int t = 0; t < 5; ++t)
#pragma unroll
        for (int rr = 0; rr < 16; ++rr) { const float pv = __builtin_amdgcn_exp2f(__builtin_fmaf(S[t][rr], ATT_C, -mx)); S[t][rr] = pv; ls += pv; }
    ls += __shfl_xor(ls, 32);
    bf16x8 pa[5][2];
#pragma unroll
    for (int t = 0; t < 5; ++t)
#pragma unroll
        for (int s2 = 0; s2 < 2; ++s2) pa[t][s2] = pack8(S[t], s2);
    __builtin_amdgcn_sched_barrier(0);
    attn_fetch<1>(an, proj, vv);
    __builtin_amdgcn_sched_barrier(0);
    f32x16 O[2]; O[0] = (f32x16){}; O[1] = (f32x16){};
    { bf16x8 vf[2][2];
#pragma unroll
      for (int db = 0; db < 2; ++db) vf[0][db] = frag_col<128, true>(lds + ATT_LV, 32 * w, 32 * db, lane);
#pragma unroll
      for (int i = 0; i < 10; ++i) { const int t = i >> 1, s2 = i & 1;
          if (i < 9) {
#pragma unroll
              for (int db = 0; db < 2; ++db) vf[(i + 1) & 1][db] = frag_col<128, true>(lds + ATT_LV, 32 * w + 16 * (i + 1), 32 * db, lane); }
          __builtin_amdgcn_sched_barrier(0);
#pragma unroll
          for (int db = 0; db < 2; ++db) O[db] = __builtin_amdgcn_mfma_f32_32x32x16_bf16(vf[i & 1][db], pa[t][s2], O[db], 0, 0, 0);
          __builtin_amdgcn_sched_barrier(0); } }
    { const float il = 1.f / ls;
      bf16* orow = OBR + ((size_t)br * M + (size_t)b * T + (size_t)((i0 + 32 * w + r32) * d + r)) * 512 + head * 64 + 8 * h;
#pragma unroll
      for (int db = 0; db < 2; ++db)
#pragma unroll
          for (int gp = 0; gp < 2; ++gp) {
              unsigned ax = pg8::cvt_pk_bf16(O[db][8 * gp] * il, O[db][8 * gp + 1] * il), ay = pg8::cvt_pk_bf16(O[db][8 * gp + 2] * il, O[db][8 * gp + 3] * il);
              unsigned bx2 = pg8::cvt_pk_bf16(O[db][8 * gp + 4] * il, O[db][8 * gp + 5] * il), by = pg8::cvt_pk_bf16(O[db][8 * gp + 6] * il, O[db][8 * gp + 7] * il);
              { const auto sx = __builtin_amdgcn_permlane32_swap(ax, bx2, false, false); ax = sx[0]; bx2 = sx[1]; }
              { const auto sy = __builtin_amdgcn_permlane32_swap(ay, by, false, false); ay = sy[0]; by = sy[1]; }
              *(u32x4*)(orow + 32 * db + 16 * gp) = (u32x4){ax, ay, bx2, by}; } }
    if (h == 0) { float* ml = ML + (((size_t)br * M + (size_t)b * T + (size_t)((i0 + 32 * w + r32) * d + r)) * 8 + head) * 2; ml[0] = mx; ml[1] = ls; }
    __syncthreads();
}
constexpr int ATT_SPLIT = ATT_UNITS / 2;
__device__ __forceinline__ void attn_units(int first, int stride, int end, const bf16* proj, bf16* OBR, float* ML, LAS unsigned char* lds) {
    if (first >= end) return;
    u32x4 kv[6], vv[6]; AttU cur = attn_decode(first); attn_fetch<0>(cur, proj, kv); attn_fetch<1>(cur, proj, vv);
#pragma unroll 1
    for (int u = first; u < end; u += stride) {
        const bool hn = u + stride < end; const AttU nxt = attn_decode(hn ? u + stride : u);
        attn_unit(cur, nxt, kv, vv, proj, OBR, ML, lds);
        cur = nxt;
    }
}
__device__ __forceinline__ void attn_merge_rows(const bf16* OBR, const float* ML, bf16* O, int gw, int NGW, int lane) {
#pragma unroll 1
    for (int m = gw; m < M; m += NGW) {
        const int head = lane >> 3; float mm[3], ll[3], mxx = -INFINITY; u32x4 ov[3];
#pragma unroll
        for (int br = 0; br < 3; ++br) { const float* ml = ML + (((size_t)br * M + m) * 8 + head) * 2; mm[br] = ml[0]; ll[br] = ml[1]; mxx = fmaxf(mxx, mm[br]);
            ov[br] = __builtin_nontemporal_load((const u32x4*)(OBR + ((size_t)br * M + m) * 512 + lane * 8)); }
        float wgt[3], wsum = 0.f;
#pragma unroll
        for (int br = 0; br < 3; ++br) { wgt[br] = ll[br] * __builtin_amdgcn_exp2f(mm[br] - mxx); wsum += wgt[br]; }
        const float iw = 1.f / wsum; float acc[8];
#pragma unroll
        for (int e = 0; e < 8; ++e) acc[e] = 0.f;
#pragma unroll
        for (int br = 0; br < 3; ++br) { const float wb = wgt[br] * iw;
#pragma unroll
            for (int e = 0; e < 4; ++e) { const unsigned pk = ov[br][e]; acc[2 * e] += wb * __uint_as_float(pk << 16); acc[2 * e + 1] += wb * __uint_as_float(pk & 0xffff0000u); } }
        u32x4 o; o.x = pk2(acc[0], acc[1]); o.y = pk2(acc[2], acc[3]); o.z = pk2(acc[4], acc[5]); o.w = pk2(acc[6], acc[7]);
        *(u32x4*)(O + (size_t)m * D + 512 + lane * 8) = o;
    }
}
constexpr int GLA_SEG = 256, GLA_NSEG = T / GLA_SEG, GLA_UNITS = BATCH * 4 * GLA_NSEG;
constexpr int GL_QP = 16384, GL_KP = 24576, GL_KPP = 32768, GL_V = 40960, GL_ST = 57344, GL_O = 73728, GL_PART = 107520, GL_GLR = 109568, GL_AL = 113664;
constexpr int GL_OLD = 132;
constexpr size_t WS_GLAS_A = WS_GLAS + 8 * MiB;
struct GLoad { f32x4 glr; u32x4 v[2]; bf16 k[8], q[8]; };
__device__ __forceinline__ float fast_logsigmoid(float z) {
    const float e = __builtin_amdgcn_exp2f(-fabsf(z) * 1.4426950408889634f);
    return fminf(z, 0.f) - __builtin_amdgcn_logf(1.f + e) * 0.6931471805599453f;
}
template <bool FULL> __device__ __forceinline__ void gla_fetch(GLoad& L, const bf16* proj, const float* glr, int b, int h, int t0) {
    const int tid = threadIdx.x, dk = tid & 63, tg = tid >> 6; const size_t row0 = (size_t)b * T + t0;
    L.glr = (f32x4){0.f, 0.f, 0.f, 0.f}; if (tid < 256) L.glr = ((const f32x4*)(glr + row0 * 16))[tid];
#pragma unroll
    for (int j = 0; j < 2; ++j) { const int c = tid + NTHREADS * j, tok = c >> 4, ch = c & 15; L.v[j] = *(const u32x4*)(proj + (row0 + tok) * NPROJ + C_GV + h * 128 + ch * 8); }
#pragma unroll
    for (int i = 0; i < 8; ++i) { const bf16* pr = proj + (row0 + tg * 8 + i) * NPROJ + h * 64 + dk; L.k[i] = pr[C_GK]; if (FULL) L.q[i] = pr[C_GQ]; }
}
template <bool FULL> __device__ __forceinline__ float gla_prep(const GLoad& L, const float (&w2r)[16], float bb, LAS unsigned char* lds) {
    const int tid = threadIdx.x, dk = tid & 63, tg = tid >> 6;
    LAS float* gl = (LAS float*)(lds + GL_GLR); LAS float* part = (LAS float*)(lds + GL_PART); LAS float* al = (LAS float*)(lds + GL_AL);
    if (tid < 256) *(LAS f32x4*)(gl + 4 * tid) = L.glr;
#pragma unroll
    for (int j = 0; j < 2; ++j) { const int c = tid + NTHREADS * j, tok = c >> 4, ch = c & 15; *(LAS u32x4*)(lds + GL_V + img_off<256>(tok, ch)) = L.v[j]; }
    __syncthreads();
    float la[8];
#pragma unroll
    for (int i = 0; i < 8; ++i) { const LAS float* g = gl + (tg * 8 + i) * 16; float z = bb;
#pragma unroll
        for (int q = 0; q < 4; ++q) { const f32x4 gv = *(const LAS f32x4*)(g + 4 * q); z += gv.x * w2r[4 * q] + gv.y * w2r[4 * q + 1] + gv.z * w2r[4 * q + 2] + gv.w * w2r[4 * q + 3]; }
        la[i] = fast_logsigmoid(z) * (1.f / 16.f); }
#pragma unroll
    for (int i = 1; i < 8; ++i) la[i] += la[i - 1];
    part[tg * 64 + dk] = la[7];
    __syncthreads();
    float offs = 0.f, glast = 0.f;
#pragma unroll
    for (int g = 0; g < 8; ++g) { const float pv = part[g * 64 + dk]; glast += pv; if (g < tg) offs += pv; }
    if (tg == 0) al[dk] = __expf(glast);
#pragma unroll
    for (int i = 0; i < 8; ++i) { const int tok = tg * 8 + i; const float G = offs + la[i];
        const float kv = bf2f(L.k[i]); const int o = img_off<128>(tok, dk >> 3) + (dk & 7) * 2;
        *(LAS bf16*)(lds + GL_KPP + o) = (bf16)pg8::cvt_pk_bf16(kv * __expf(glast - G), 0.f);
        if (FULL) { const float qv = bf2f(L.q[i]) * 0.125f; *(LAS bf16*)(lds + GL_QP + o) = (bf16)pg8::cvt_pk_bf16(qv * __expf(G), 0.f); *(LAS bf16*)(lds + GL_KP + o) = (bf16)pg8::cvt_pk_bf16(kv * __expf(-G), 0.f); } }
    return glast;
}
__device__ __forceinline__ void gla_state_update(f32x16& Sacc, LAS unsigned char* lds, int rb, int cb, int lane) {
    f32x16 U = (f32x16){};
#pragma unroll
    for (int s = 0; s < 4; ++s) U = __builtin_amdgcn_mfma_f32_32x32x16_bf16(frag_col<128, false>(lds + GL_KPP, 16 * s, 32 * rb, lane), frag_col<256, false>(lds + GL_V, 16 * s, 32 * cb, lane), U, 0, 0, 0);
    const LAS float* al = (const LAS float*)(lds + GL_AL);
#pragma unroll
    for (int r = 0; r < 16; ++r) Sacc[r] = al[32 * rb + crow(r, lane >> 5)] * Sacc[r] + U[r];
}
__device__ __forceinline__ void gla_pass1_unit(int u, const Args& a, LAS unsigned char* lds) {
    const int tid = threadIdx.x, lane = tid & 63, w = __builtin_amdgcn_readfirstlane(tid >> 6), rb = w >> 2, cb = w & 3;
    const int seg = u % GLA_NSEG, bh = u / GLA_NSEG, b = bh >> 2, h = bh & 3, dk = tid & 63;
    const bf16* proj = (const bf16*)(a.ws + WS_PROJ); const float* glr = (const float*)(a.ws + WS_GLR);
    float w2r[16];
#pragma unroll
    for (int r = 0; r < 16; ++r) w2r[r] = a.in[3][r * 256 + h * 64 + dk];
    const float bb = a.in[4][h * 64 + dk];
    f32x16 Sacc = (f32x16){}; float gsum = 0.f;
    GLoad L; gla_fetch<false>(L, proj, glr, b, h, seg * GLA_SEG);
#pragma unroll 1
    for (int c = 0; c < GLA_SEG / 64; ++c) {
        gsum += gla_prep<false>(L, w2r, bb, lds);
        if (c + 1 < GLA_SEG / 64) gla_fetch<false>(L, proj, glr, b, h, seg * GLA_SEG + (c + 1) * 64);
        __syncthreads();
        gla_state_update(Sacc, lds, rb, cb, lane);
        __syncthreads();
    }
    float* U = (float*)(a.ws + WS_GLAS) + (size_t)u * 64 * 128;
#pragma unroll
    for (int r = 0; r < 16; ++r) U[(32 * rb + crow(r, lane >> 5)) * 128 + 32 * cb + (lane & 31)] = Sacc[r];
    if (tid < 64) ((float*)(a.ws + WS_GLAS_A))[(size_t)u * 64 + dk] = __expf(gsum);
}
__device__ __forceinline__ void gla_pass2_unit(int u, const Args& a, LAS unsigned char* lds) {
    const int tid = threadIdx.x, lane = tid & 63, w = __builtin_amdgcn_readfirstlane(tid >> 6), rb = w >> 2, cb = w & 3, r32 = lane & 31, hh = lane >> 5;
    const int seg = u % GLA_NSEG, bh = u / GLA_NSEG, b = bh >> 2, h = bh & 3, dk = tid & 63;
    const bf16* proj = (const bf16*)(a.ws + WS_PROJ); const float* glr = (const float*)(a.ws + WS_GLR); bf16* Oo = (bf16*)(a.ws + WS_O);
    float w2r[16];
#pragma unroll
    for (int r = 0; r < 16; ++r) w2r[r] = a.in[3][r * 256 + h * 64 + dk];
    const float bb = a.in[4][h * 64 + dk];
    const int etok = tid >> 3, epart = tid & 7;
    float gn[16];
#pragma unroll
    for (int i = 0; i < 16; ++i) gn[i] = a.in[5][epart * 16 + i];
    f32x16 Sacc;
    { const float* Us = (const float*)(a.ws + WS_GLAS) + (size_t)u * 64 * 128;
#pragma unroll
      for (int r = 0; r < 16; ++r) Sacc[r] = Us[(32 * rb + crow(r, hh)) * 128 + 32 * cb + r32]; }
    GLoad L; gla_fetch<true>(L, proj, glr, b, h, seg * GLA_SEG);
#pragma unroll 1
    for (int c = 0; c < GLA_SEG / 64; ++c) {
        const int t0 = seg * GLA_SEG + c * 64;
#pragma unroll
        for (int g4 = 0; g4 < 4; ++g4) { u32x2 pk; pk.x = pg8::cvt_pk_bf16(Sacc[4 * g4], Sacc[4 * g4 + 1]); pk.y = pg8::cvt_pk_bf16(Sacc[4 * g4 + 2], Sacc[4 * g4 + 3]);
            *(LAS u32x2*)(lds + GL_ST + img_off<128>(32 * cb + r32, 4 * rb + g4) + 8 * hh) = pk; }
        (void)gla_prep<true>(L, w2r, bb, lds);
        if (c + 1 < GLA_SEG / 64) gla_fetch<true>(L, proj, glr, b, h, t0 + 64);
        const size_t erow = (size_t)b * T + t0 + etok;
        const u32x4* gp = (const u32x4*)(proj + erow * NPROJ + C_GR + h * 128 + epart * 16); const u32x4 g0 = gp[0], g1 = gp[1];
        __syncthreads();
        f32x16 Oa = (f32x16){};
#pragma unroll
        for (int t = 0; t < 2; ++t) if (t <= rb) {
            f32x16 X = (f32x16){};
#pragma unroll
            for (int s = 0; s < 4; ++s) X = __builtin_amdgcn_mfma_f32_32x32x16_bf16(frag_row<128>(lds + GL_KP, 32 * t, 16 * s, lane), frag_row<128>(lds + GL_QP, 32 * rb, 16 * s, lane), X, 0, 0, 0);
            if (t == rb) {
#pragma unroll
                for (int r = 0; r < 16; ++r) X[r] = crow(r, hh) <= r32 ? X[r] : 0.f; }
#pragma unroll
            for (int s2 = 0; s2 < 2; ++s2) Oa = __builtin_amdgcn_mfma_f32_32x32x16_bf16(pack8(X, s2), frag_col<256, true>(lds + GL_V, 32 * t + 16 * s2, 32 * cb, lane), Oa, 0, 0, 0);
        }
#pragma unroll
        for (int s = 0; s < 4; ++s) Oa = __builtin_amdgcn_mfma_f32_32x32x16_bf16(frag_row<128>(lds + GL_QP, 32 * rb, 16 * s, lane), frag_row<128>(lds + GL_ST, 32 * cb, 16 * s, lane), Oa, 0, 0, 0);
        gla_state_update(Sacc, lds, rb, cb, lane);
        { LAS float* ol = (LAS float*)(lds + GL_O);
#pragma unroll
          for (int r = 0; r < 16; ++r) ol[(32 * rb + crow(r, hh)) * GL_OLD + 32 * cb + r32] = Oa[r]; }
        __syncthreads();
        { const LAS float* ol = (const LAS float*)(lds + GL_O) + etok * GL_OLD + epart * 16; float ov[16]; float ss = 0.f;
#pragma unroll
          for (int q = 0; q < 4; ++q) { const f32x4 t4 = *(const LAS f32x4*)(ol + 4 * q); ov[4 * q] = t4.x; ov[4 * q + 1] = t4.y; ov[4 * q + 2] = t4.z; ov[4 * q + 3] = t4.w; ss += (t4.x * t4.x + t4.y * t4.y) + (t4.z * t4.z + t4.w * t4.w); }
          ss += __shfl_xor(ss, 1); ss += __shfl_xor(ss, 2); ss += __shfl_xor(ss, 4);
          const float rstd = rsqrtf(ss * (1.f / 128.f) + EPS);
          const size_t row = erow;
          const unsigned gw_[8] = {g0.x, g0.y, g0.z, g0.w, g1.x, g1.y, g1.z, g1.w}; float res[16];
#pragma unroll
          for (int i = 0; i < 8; ++i) { const float ga = __uint_as_float(gw_[i] << 16), gb = __uint_as_float(gw_[i] & 0xffff0000u);
              res[2 * i] = ov[2 * i] * rstd * gn[2 * i] * (ga * __builtin_amdgcn_rcpf(1.f + __expf(-ga))); res[2 * i + 1] = ov[2 * i + 1] * rstd * gn[2 * i + 1] * (gb * __builtin_amdgcn_rcpf(1.f + __expf(-gb))); }
          u32x4 o0, o1; o0.x = pk2(res[0], res[1]); o0.y = pk2(res[2], res[3]); o0.z = pk2(res[4], res[5]); o0.w = pk2(res[6], res[7]);
          o1.x = pk2(res[8], res[9]); o1.y = pk2(res[10], res[11]); o1.z = pk2(res[12], res[13]); o1.w = pk2(res[14], res[15]);
          u32x4* op = (u32x4*)(Oo + row * D + h * 128 + epart * 16); op[0] = o0; op[1] = o1; }
    }
    __syncthreads();
}
__device__ __forceinline__ void gla_scan(const Args& a, int blk) {
    if (blk >= BATCH * 4 * 16) return;
    const int bh = blk >> 4, elem = (blk & 15) * NTHREADS + threadIdx.x, dk = elem >> 7;
    float* U = (float*)(a.ws + WS_GLAS) + (size_t)bh * GLA_NSEG * 8192 + elem; const float* A = (const float*)(a.ws + WS_GLAS_A) + (size_t)bh * GLA_NSEG * 64 + dk;
    float uv[GLA_NSEG], av[GLA_NSEG];
#pragma unroll
    for (int j = 0; j < GLA_NSEG; ++j) { uv[j] = U[(size_t)j * 8192]; av[j] = A[j * 64]; }
    float S = 0.f;
#pragma unroll
    for (int j = 0; j < GLA_NSEG; ++j) { U[(size_t)j * 8192] = S; S = av[j] * S + uv[j]; }
}
__global__ void __launch_bounds__(NTHREADS, 2) fwd(Args args) {
    extern __shared__ __attribute__((aligned(16))) unsigned char lds_raw[];
    LAS unsigned char* lds = (LAS unsigned char*)lds_raw;
    const int tid = threadIdx.x;
    const int G = gridDim.x; const int bx = blockIdx.x; const int vcu = (G % 8 == 0) ? (bx % 8) * (G / 8) + bx / 8 : bx;
    unsigned char* ws = args.ws;
    unsigned* ctl = (unsigned*)(ws + WS_CTL);
    for (int u = tid; u < (LDS_BYTES - LDSCTL_OFF) / 4; u += NTHREADS) ((LAS unsigned*)(lds + LDSCTL_OFF))[u] = 0u;
    __syncthreads();
    const int lo = args.ph_lo, hi = args.ph_hi;
    XcdBarrier bar; bar.bar = ctl + CW_BAR; bar.x = 0; bar.st = nullptr;
    if (hi - lo > 1) bar = xcd_barrier_post(ctl + CW_BAR, (volatile LAS unsigned*)(lds + LDSCTL_OFF + 64));
#define IN(k) (lo <= (k) && (k) < hi)
#define SEAM(k) do { if (IN(k) && IN((k) + 1)) xcd_barrier(bar); } while (0)
    bf16* OBR = (bf16*)args.out; float* MLp = (float*)((unsigned char*)args.out + 48 * MiB);
    if (IN(0)) { p0_prologue(args, lds, vcu, G); SEAM(0); }
    if (IN(1)) {
        constexpr int NEI = NE * 16 * 32 + NE * 8 * 32;
        const int grp = (G >= 16) ? ((bx >> 3) & 1) : 0, ngrp = (G >= 16) ? 2 : 1, rank = (G >= 16) ? ((bx >> 4) * 8 + (bx & 7)) : bx, per = (G >= 16) ? G / 2 : G;
        const int wv = __builtin_amdgcn_readfirstlane(tid >> 6);
        const int e_lo = grp * (NEI / ngrp), e_hi = (grp + 1) * (NEI / ngrp);
        if (grp == 0) { p0_expert_items(args, lds, e_lo + rank * NWAVES + wv, per * NWAVES, e_hi); __syncthreads(); }
        pg8::DenseOrder S; S.init(ws + WS_N1, ws + WS_WIN, M, NPROJ, D, G, bx);
        pg8::EpiBf16 E{(bf16*)(ws + WS_PROJ), NPROJ};
        pg8::gemm_phase<pg8::EpiBf16, pg8::DenseOrder, true>(lds, D, S, E);
        if (grp == 1) { __syncthreads(); p0_expert_items(args, lds, e_lo + rank * NWAVES + wv, per * NWAVES, e_hi); }
        SEAM(1);
    }
    if (IN(2)) {
        for (int i = bx; i < GLA_UNITS; i += G) gla_pass1_unit(i, args, lds);
        SEAM(2);
    }
    if (IN(3)) {
        for (int blk = bx; blk < BATCH * 4 * 16; blk += G) gla_scan(args, blk);
        attn_units(bx, G, ATT_UNITS, (const bf16*)(ws + WS_PROJ), OBR, MLp, lds);
        SEAM(3);
    }
    if (IN(4)) {
        const bool merge_first = (bx >> 3) & 1;
        if (merge_first) attn_merge_rows((const bf16*)args.out, (const float*)((unsigned char*)args.out + 48 * MiB), (bf16*)(ws + WS_O), vcu * NWAVES + (tid >> 6), G * NWAVES, tid & 63);
        for (int u = bx; u < GLA_UNITS; u += G) gla_pass2_unit(u, args, lds);
        if (!merge_first) attn_merge_rows((const bf16*)args.out, (const float*)((unsigned char*)args.out + 48 * MiB), (bf16*)(ws + WS_O), vcu * NWAVES + (tid >> 6), G * NWAVES, tid & 63);
        SEAM(4);
    }
    if (IN(5)) {
        pg8::DenseOrder S; S.init(ws + WS_O, ws + WS_WOUT, M, D, D, G, bx);
        pg8::EpiBf16 E{(bf16*)args.out, 2 * D};
        pg8::gemm_phase<pg8::EpiBf16, pg8::DenseOrder, false>(lds, D, S, E);
        SEAM(5);
    }
    if (IN(6)) { p5_router(args, lds, vcu, G); SEAM(6); }
    if (IN(7)) {
        moe_prefix(args, lds, G);
        pg8::MoeOrder S{(const LAS int*)(lds + LDS_PB), (const LAS int*)(lds + LDS_PBA), (const LAS int*)(lds + LDS_CNT), (const int*)(ws + WS_LIST), (const char*)(ws + WS_N2), (const char*)(ws + WS_W13), D, 4, G, vcu, 1, (size_t)D * D * 2};
        pg8::EpiMoeUp E{(bf16*)(ws + WS_HID), (const float*)(ws + WS_LRS), (const float*)(ws + WS_LGW), (const LAS int*)(lds + LDS_PBA)};
        pg8::gemm_phase<pg8::EpiMoeUp, pg8::MoeOrder, true>(lds, D, S, E);
        moe_tail_tasks<true>(args, lds, vcu, G);
        SEAM(7);
    }
    if (IN(8)) {
        if (!IN(7)) moe_prefix(args, lds, G);
        pg8::MoeOrder S{(const LAS int*)(lds + LDS_PB), (const LAS int*)(lds + LDS_PBA), (const LAS int*)(lds + LDS_CNT), (const int*)(ws + WS_LIST), (const char*)(ws + WS_HID), (const char*)(ws + WS_W2), FF, 4, G, vcu, 0, (size_t)D * FF * 2};
        pg8::EpiMoeDown E{(bf16*)(ws + WS_Y), (const int*)(ws + WS_LIST)};
        pg8::gemm_phase<pg8::EpiMoeDown, pg8::MoeOrder, true>(lds, FF, S, E);
        moe_tail_tasks<false>(args, lds, vcu, G);
        SEAM(8);
    }
    if (IN(9)) { p8_final(args, vcu, G, args.out); }
#undef IN
#undef SEAM
}
static void launch_fwd(const Args& base, int lo, int hi, int grid, hipStream_t stream) {
    Args a = base; a.ph_lo = lo; a.ph_hi = hi;
    hipLaunchKernelGGL(fwd, dim3(grid), dim3(NTHREADS), LDS_BYTES, stream, a);
}
extern "C" void kernel_launch(void* const* d_in, const int* in_sizes, int n_in, void* d_out, int out_size, void* d_ws, size_t ws_size, hipStream_t stream) {
    if (n_in != 16 || in_sizes[0] != M * D || out_size != M * D || ws_size < WS_END) { fprintf(stderr, "kernel_launch: unexpected shapes (n_in %d, ws %zu)\n", n_in, ws_size); return; }
    static int grid = 0;
    if (grid == 0) {
        int dev = 0, cus = 0;
        if (hipGetDevice(&dev) != hipSuccess || hipDeviceGetAttribute(&cus, hipDeviceAttributeMultiprocessorCount, dev) != hipSuccess) { grid = -1; return; }
        if (hipFuncSetAttribute((const void*)fwd, hipFuncAttributeMaxDynamicSharedMemorySize, LDS_BYTES) != hipSuccess) { fprintf(stderr, "kernel_launch: hipFuncSetAttribute failed\n"); grid = -1; return; }
        int per_cu = 0;
        if (hipOccupancyMaxActiveBlocksPerMultiprocessor(&per_cu, (const void*)fwd, NTHREADS, LDS_BYTES) != hipSuccess || per_cu < 1) fprintf(stderr, "kernel_launch: occupancy query says %d\n", per_cu);
        (void)hipGetLastError();
        grid = cus;
    }
    if (grid < 0) return;
    unsigned char* ws = (unsigned char*)d_ws; float* out = (float*)d_out;
    (void)hipMemsetAsync(ws + WS_CTL, 0, CTL_BYTES, stream);
    Args a{};
    for (int i = 0; i < 16; ++i) a.in[i] = (const float*)d_in[i];
    a.out = out; a.ws = ws;
    launch_fwd(a, 0, 10, grid, stream);
}
```

```cpp
#include <hip/hip_runtime.h>
#include <stdint.h>
#include <stdio.h>

typedef unsigned short bf16;
typedef short bf16x8 __attribute__((ext_vector_type(8)));
typedef float f32x4 __attribute__((ext_vector_type(4)));

__device__ __forceinline__ float bf2f(bf16 b) { return __uint_as_float(((unsigned)b) << 16); }
__device__ __forceinline__ bf16 f2bf(float f) { unsigned u = __float_as_uint(f); u += 0x7fffu + ((u >> 16) & 1u); return (bf16)(u >> 16); }

constexpr int BATCH = 2, T = 8192, M = BATCH * T, D = 1024;
constexpr int INC = 3088;
constexpr int NPROJ = 3072;
constexpr int C_GQ = 0, C_GK = 256, C_GV = 512, C_GR = 1024, C_AQ = 1536, C_AK = 2048, C_AV = 2560;
constexpr int GLR_SRC = 1536;
constexpr int NE = 32, FF = 512;
constexpr float EPS = 1e-6f;
constexpr int LIST_CAP = 16384;

constexpr size_t MiB = 1u << 20;
constexpr size_t WS_CTL = 0, CTL_BYTES = 1 * MiB;
constexpr size_t WS_WRT = 1 * MiB;
constexpr size_t WS_WOUT = 2 * MiB;
constexpr size_t WS_W13 = 4 * MiB;
constexpr size_t WS_W2 = 68 * MiB;
constexpr size_t WS_R = 100 * MiB;
constexpr size_t WS_WIN = WS_R;
constexpr size_t WS_GLR = WS_R + 6 * MiB;
constexpr size_t WS_GLAS = WS_R + 7 * MiB;
constexpr size_t WS_N1 = WS_R + 16 * MiB;
constexpr size_t WS_O = WS_N1;
constexpr size_t WS_PROJ = WS_R + 48 * MiB;
constexpr size_t WS_Y = WS_R;
constexpr size_t WS_N2 = WS_R + 64 * MiB;
constexpr size_t WS_HID = WS_R + 96 * MiB;
constexpr size_t WS_ROUTE = WS_R + 136 * MiB;
constexpr size_t WS_RSTD = WS_ROUTE + 512 * 1024;
constexpr size_t WS_LIST = WS_R + 137 * MiB;
constexpr size_t WS_LRS = WS_R + 139 * MiB;
constexpr size_t WS_LGW = WS_R + 141 * MiB;
constexpr size_t WS_END = WS_R + 144 * MiB;
constexpr int CW_CNT = 64;

struct Route { int e0, e1; float w0, w1; };

__device__ __forceinline__ float wave_sum(float v) {
#pragma unroll
    for (int o = 1; o < 64; o <<= 1) v += __shfl_xor(v, o);
    return v;
}
__device__ __forceinline__ float logsigmoid(float z) { return fminf(z, 0.f) - log1pf(__expf(-fabsf(z))); }
#define LAS __attribute__((address_space(3)))
#define GAS __attribute__((address_space(1)))
typedef unsigned u32x4 __attribute__((ext_vector_type(4)));
typedef unsigned u32x2 __attribute__((ext_vector_type(2)));
namespace pg8 {
constexpr int BM = 256, BK = 64, HALF = 128, HTB = HALF * BK * 2, STAGE_BYTES = 8 * HTB, NXCD = 8, WGM = 8;
__host__ __device__ __forceinline__ int lds_byte(int r, int c) { const int st = (r >> 4) * 2 + (c >> 5), rr = r & 15, cc = c & 31, ob = rr * 64 + cc * 2; return st * 1024 + (ob ^ (((ob >> 9) & 1) << 5)); }
__host__ __device__ __forceinline__ void stage_rc(int b, int& R, int& C) { const int st = b / 1024, sb = b % 1024, swz = sb ^ (((sb >> 9) & 1) << 5); R = (st >> 1) * 16 + swz / 64; C = (st & 1) * 32 + (swz % 64) / 2; }
__host__ __device__ __forceinline__ int perm32(int rho) { const int n = rho >> 4, i = rho & 15; return 8 * (i >> 2) + 4 * n + (i & 3); }
struct Unit { int pm, pn, e, nrows; };
typedef float f32x2_t __attribute__((ext_vector_type(2))); typedef __bf16 bf16x2_t __attribute__((ext_vector_type(2)));
__device__ __forceinline__ unsigned cvt_pk_bf16(float lo, float hi) { const f32x2_t v = {lo, hi}; const bf16x2_t b = __builtin_convertvector(v, bf16x2_t); return __builtin_bit_cast(unsigned, b); }

__device__ __forceinline__ void st16_wt(void* p, u32x4 v) { asm volatile("global_store_dwordx4 %0, %1, off sc1\n\ts_nop 1" :: "v"(p), "v"(v) : "memory"); }

struct DenseOrder {
    int nM, nN, nwg, G, c, K; const char* A; const char* Bt;
    __device__ void init(const void* A_, const void* Bt_, int M_, int N_, int K_, int G_, int c_) { A = (const char*)A_; Bt = (const char*)Bt_; nM = M_ / BM; nN = N_ / BM; nwg = nM * nN; G = G_; c = c_; K = K_; }
    __device__ __forceinline__ bool next(int i, Unit& u) const {
        const long L = (long)i * G + c; if (L >= nwg) return false;
        int wgid = (int)L; { const int q = nwg / NXCD, r = nwg % NXCD, xcd = wgid % NXCD, off = wgid / NXCD; wgid = (xcd < r ? xcd * (q + 1) : r * (q + 1) + (xcd - r) * q) + off; }
        const int nig = WGM * nN, gid = wgid / nig, fm = gid * WGM, gsz = (nM - fm) < WGM ? (nM - fm) : WGM;
        u.pm = fm + ((wgid % nig) % gsz); u.pn = (wgid % nig) / gsz; u.e = 0; u.nrows = 256; return true;
    }
    __device__ __forceinline__ void a_off(const Unit& u, const int (&R)[2], const int (&C)[2], unsigned (&off)[2][2]) const {
#pragma unroll
        for (int h = 0; h < 2; ++h)
#pragma unroll
            for (int i = 0; i < 2; ++i) off[h][i] = (unsigned)(((u.pm * BM + h * HALF + R[i]) * K + C[i]) * 2);
    }
    __device__ __forceinline__ const char* a_base() const { return A; }
    __device__ __forceinline__ const char* b_base(const Unit& u) const { return Bt + (size_t)u.pn * BM * K * 2; }
};

struct EpiBf16 {
    static constexpr bool PERM = true;
    bf16* O; int ldc;
    __device__ __forceinline__ void operator()(const f32x4 (&acc)[2][2][4][2], const Unit& u, int wr, int wc, int fr, int fq) const {
        const int row0 = u.pm * BM + wr * 64 + fr, col0 = u.pn * BM + wc * 32 + 8 * fq;
#pragma unroll
        for (int ai = 0; ai < 2; ++ai)
#pragma unroll
            for (int m = 0; m < 4; ++m) { bf16* rowp = O + (size_t)(row0 + ai * HALF + m * 16) * ldc + col0;
#pragma unroll
                for (int bj = 0; bj < 2; ++bj) { const f32x4 v0 = acc[ai][bj][m][0], v1 = acc[ai][bj][m][1];
                    u32x4 w; w.x = cvt_pk_bf16(v0[0], v0[1]); w.y = cvt_pk_bf16(v0[2], v0[3]); w.z = cvt_pk_bf16(v1[0], v1[1]); w.w = cvt_pk_bf16(v1[2], v1[3]);
                    st16_wt(rowp + bj * HALF, w); } }
    }
};

struct EpiResBf16 {
    static constexpr bool PERM = true;
    const float* X; bf16* H;
    __device__ __forceinline__ void operator()(const f32x4 (&acc)[2][2][4][2], const Unit& u, int wr, int wc, int fr, int fq) const {
        const int row0 = u.pm * BM + wr * 64 + fr, col0 = u.pn * BM + wc * 32 + 8 * fq;
        f32x4 xv[2][8];
#define RES_LOAD(b, dst) { _Pragma("unroll") for (int mm = 0; mm < 2; ++mm) { const float* xp = X + (size_t)(row0 + ((b) >> 1) * HALF + (2 * ((b) & 1) + mm) * 16) * D + col0; \
            _Pragma("unroll") for (int bj = 0; bj < 2; ++bj) { dst[mm * 4 + bj * 2] = __builtin_nontemporal_load((const f32x4*)(xp + bj * HALF)); dst[mm * 4 + bj * 2 + 1] = __builtin_nontemporal_load((const f32x4*)(xp + bj * HALF + 4)); } } }
        RES_LOAD(0, xv[0]);
#pragma unroll
        for (int b = 0; b < 4; ++b) {
            if (b + 1 < 4) RES_LOAD(b + 1, xv[(b + 1) & 1]);
            const int ai = b >> 1;
#pragma unroll
            for (int mm = 0; mm < 2; ++mm) { const int m = 2 * (b & 1) + mm; bf16* rowp = H + (size_t)(row0 + ai * HALF + m * 16) * D + col0;
#pragma unroll
                for (int bj = 0; bj < 2; ++bj) { const f32x4 v0 = acc[ai][bj][m][0] + xv[b & 1][mm * 4 + bj * 2], v1 = acc[ai][bj][m][1] + xv[b & 1][mm * 4 + bj * 2 + 1];
                    u32x4 w; w.x = cvt_pk_bf16(v0[0], v0[1]); w.y = cvt_pk_bf16(v0[2], v0[3]); w.z = cvt_pk_bf16(v1[0], v1[1]); w.w = cvt_pk_bf16(v1[2], v1[3]);
                    st16_wt(rowp + bj * HALF, w); } }
        }
#undef RES_LOAD
    }
};

template <class Epi, class Sched, bool ALIGN_EPI>
__device__ __forceinline__ void gemm_phase(LAS unsigned char* lds, int K, const Sched& S, const Epi& E) {
    const int tid = threadIdx.x, wid = __builtin_amdgcn_readfirstlane(tid >> 6), lane = tid & 63, wr = wid >> 2, wc = wid & 3, fr = lane & 15, fq = lane >> 4;
    const int nt = K / BK;
    int Rr[2], Cc[2]; unsigned voffB[2];
#pragma unroll
    for (int i = 0; i < 2; ++i) { int R, C; stage_rc(tid * 16 + i * 8192, R, C); const int Rb = Epi::PERM ? ((R & ~31) + perm32(R & 31)) : R; Rr[i] = R; Cc[i] = C; voffB[i] = (unsigned)(Rb * K + C) * 2u; }
    const size_t kstep = (size_t)(BK * 2);
    const size_t hstep = (size_t)HALF * K * 2;
    const unsigned ldsw = (unsigned)wid * 1024u;
    const int aoff = lds_byte(wr * 64 + fr, fq * 8), boff = lds_byte(wc * 32 + fr, fq * 8);
    const char* const Ab = S.a_base();
#define PG8_SA(b, h) (((b) * 2 + (h)) * HTB)
#define PG8_SB(b, h) ((4 + (b) * 2 + (h)) * HTB)
#define PG8_STAGE_B(bufoff, gbase) do { _Pragma("unroll") for (int _i = 0; _i < 2; ++_i) \
        __builtin_amdgcn_global_load_lds((const unsigned*)((const char*)(gbase) + voffB[_i]), (LAS unsigned*)(lds + (bufoff) + ldsw + _i * 8192), 16, 0, 0); } while (0)
#define PG8_STAGE_A(bufoff, o0, o1, kb) do { \
        __builtin_amdgcn_global_load_lds((const unsigned*)(Ab + (o0) + (kb)), (LAS unsigned*)(lds + (bufoff) + ldsw), 16, 0, 0); \
        __builtin_amdgcn_global_load_lds((const unsigned*)(Ab + (o1) + (kb)), (LAS unsigned*)(lds + (bufoff) + ldsw + 8192), 16, 0, 0); } while (0)
#define PG8_LDA(dst, b, h) do { _Pragma("unroll") for (int m = 0; m < 4; ++m) _Pragma("unroll") for (int k = 0; k < 2; ++k) dst[m][k] = *(const LAS bf16x8*)(lds + PG8_SA(b, h) + aoff + m * 2048 + k * 1024); } while (0)
#define PG8_LDB(dst, b, h) do { _Pragma("unroll") for (int n = 0; n < 2; ++n) _Pragma("unroll") for (int k = 0; k < 2; ++k) dst[n][k] = *(const LAS bf16x8*)(lds + PG8_SB(b, h) + boff + n * 2048 + k * 1024); } while (0)
#define PG8_MMA(ai, bj, At, Bt) do { __builtin_amdgcn_s_setprio(1); _Pragma("unroll") for (int m = 0; m < 4; ++m) _Pragma("unroll") for (int n = 0; n < 2; ++n) _Pragma("unroll") for (int k = 0; k < 2; ++k) \
        acc[ai][bj][m][n] = __builtin_amdgcn_mfma_f32_16x16x32_bf16(Bt[n][k], At[m][k], acc[ai][bj][m][n], 0, 0, 0); __builtin_amdgcn_s_setprio(0); } while (0)
#define PG8_WAIT_V(n) asm volatile("s_waitcnt vmcnt(" #n ")" ::: "memory")
#define PG8_WAIT_L(n) asm volatile("s_waitcnt lgkmcnt(" #n ")" ::: "memory")
#define PG8_BAR __builtin_amdgcn_s_barrier()
#define PG8_SCHED __builtin_amdgcn_sched_barrier(0)
    Unit cur, nxt; int ui = 0;
    if (!S.next(0, cur)) return;
    f32x4 acc[2][2][4][2];
#pragma unroll
    for (int a = 0; a < 2; ++a)
#pragma unroll
        for (int b = 0; b < 2; ++b)
#pragma unroll
            for (int m = 0; m < 4; ++m)
#pragma unroll
                for (int n = 0; n < 2; ++n) acc[a][b][m][n] = (f32x4){0.f, 0.f, 0.f, 0.f};
    bf16x8 At[4][2], B0[2][2], B1[2][2];
    unsigned oc[2][2], on[2][2];
    S.a_off(cur, Rr, Cc, oc);
    const char* cB = S.b_base(cur);
    PG8_STAGE_B(PG8_SB(0, 0), cB); PG8_STAGE_B(PG8_SB(0, 1), cB + hstep); PG8_STAGE_A(PG8_SA(0, 0), oc[0][0], oc[0][1], 0); PG8_STAGE_A(PG8_SA(0, 1), oc[1][0], oc[1][1], 0);
    if (wr == 1) PG8_BAR;
    PG8_WAIT_V(2); PG8_BAR;
    PG8_STAGE_B(PG8_SB(1, 0), cB + kstep); PG8_STAGE_A(PG8_SA(1, 0), oc[0][0], oc[0][1], kstep); PG8_STAGE_B(PG8_SB(1, 1), cB + hstep + kstep);
    PG8_WAIT_V(6); PG8_BAR;
    for (;;) {
        const bool has_next = S.next(ui + 1, nxt);
        const char* nB = cB;
        if (has_next) { S.a_off(nxt, Rr, Cc, on); nB = S.b_base(nxt); }
        else {
#pragma unroll
            for (int h = 0; h < 2; ++h)
#pragma unroll
                for (int i = 0; i < 2; ++i) on[h][i] = oc[h][i]; }
        for (int t = 0; t < nt; t += 2) {
            const bool last = (t == nt - 2);
            const size_t k1 = (size_t)(t + 1) * kstep;
            const size_t k2 = last ? 0 : (size_t)(t + 2) * kstep, k3 = k2 + kstep;
            const char* b2 = last ? nB : cB + (size_t)(t + 2) * kstep; const char* b3 = b2 + kstep;
            const unsigned a20 = last ? on[0][0] : oc[0][0], a21 = last ? on[0][1] : oc[0][1], a30 = last ? on[1][0] : oc[1][0], a31 = last ? on[1][1] : oc[1][1];
            PG8_LDB(B0, 0, 0); PG8_LDB(B1, 0, 1); PG8_SCHED; PG8_LDA(At, 0, 0); PG8_STAGE_A(PG8_SA(1, 1), oc[1][0], oc[1][1], k1);
            PG8_WAIT_V(8); PG8_WAIT_L(0); PG8_BAR; PG8_MMA(0, 0, At, B0); PG8_MMA(0, 1, At, B1); PG8_BAR; PG8_SCHED;
            PG8_LDA(At, 0, 1); PG8_STAGE_B(PG8_SB(0, 0), b2); PG8_STAGE_B(PG8_SB(0, 1), b2 + hstep); PG8_STAGE_A(PG8_SA(0, 0), a20, a21, k2);
            PG8_WAIT_V(8); PG8_WAIT_L(0); PG8_BAR; PG8_MMA(1, 0, At, B0); PG8_MMA(1, 1, At, B1); PG8_BAR; PG8_SCHED;
            PG8_LDB(B0, 1, 0); PG8_LDB(B1, 1, 1); PG8_SCHED; PG8_LDA(At, 1, 0); PG8_STAGE_A(PG8_SA(0, 1), a30, a31, k2);
            PG8_WAIT_V(8); PG8_WAIT_L(0); PG8_BAR; PG8_MMA(0, 0, At, B0); PG8_MMA(0, 1, At, B1); PG8_BAR; PG8_SCHED;
            PG8_LDA(At, 1, 1); PG8_STAGE_B(PG8_SB(1, 0), b3); PG8_STAGE_B(PG8_SB(1, 1), b3 + hstep); PG8_STAGE_A(PG8_SA(1, 0), a20, a21, k3);
            PG8_WAIT_V(8); PG8_WAIT_L(0); PG8_BAR; PG8_MMA(1, 0, At, B0); PG8_MMA(1, 1, At, B1); PG8_BAR; PG8_SCHED;
        }
        if constexpr (ALIGN_EPI) { if (wr == 0) PG8_BAR; }
        E(acc, cur, wr, wc, fr, fq);
        if (!has_next) break;
#pragma unroll
        for (int a = 0; a < 2; ++a)
#pragma unroll
            for (int b = 0; b < 2; ++b)
#pragma unroll
                for (int m = 0; m < 4; ++m)
#pragma unroll
                    for (int n = 0; n < 2; ++n) acc[a][b][m][n] = (f32x4){0.f, 0.f, 0.f, 0.f};
        cur = nxt; cB = nB; ++ui;
#pragma unroll
        for (int h = 0; h < 2; ++h)
#pragma unroll
            for (int i = 0; i < 2; ++i) oc[h][i] = on[h][i];
        if constexpr (ALIGN_EPI) { if (wr == 1) PG8_BAR; }
    }
    PG8_WAIT_V(0);
    if constexpr (!ALIGN_EPI) { if (wr == 0) PG8_BAR; }
    PG8_BAR;
#undef PG8_SA
#undef PG8_SB
#undef PG8_STAGE_A
#undef PG8_STAGE_B
#undef PG8_LDA
#undef PG8_LDB
#undef PG8_MMA
#undef PG8_WAIT_V
#undef PG8_WAIT_L
#undef PG8_BAR
#undef PG8_SCHED
}
}
constexpr int NWAVES = 8, NTHREADS = NWAVES * 64;
constexpr int RING_BYTES = 131072;
constexpr int LDS_BYTES = 163840;
constexpr int LDSCTL_OFF = 162816;
constexpr int CW_BAR = 4096;
typedef GAS unsigned gu32;
#define RLX_AGENT __ATOMIC_RELAXED, __HIP_MEMORY_SCOPE_AGENT
#define LDS_WAIT() asm volatile("s_waitcnt lgkmcnt(0)" ::: "memory")
#define VM_WAIT() asm volatile("s_waitcnt vmcnt(0)" ::: "memory")
__device__ __forceinline__ unsigned pk2(float lo, float hi) { return pg8::cvt_pk_bf16(lo, hi); }

#define XB_TMO      128
#define XB_XCNT(j)  (256  + 64 * (j))
#define XB_XSUB(j)  (1280 + 64 * (j))
#define XB_XGEN(j)  (2304 + 64 * (j))
#define XB_TOP      3328
#define XB_TOPGEN   3392
#define XCD_BAR_WORDS 3456
#define XB_SPIN_CAP (1u << 18)
__device__ __forceinline__ unsigned xb_ld(unsigned* p)              { return __hip_atomic_load(p, __ATOMIC_RELAXED, __HIP_MEMORY_SCOPE_AGENT); }
__device__ __forceinline__ unsigned xb_add(unsigned* p, unsigned v) { return __hip_atomic_fetch_add(p, v, __ATOMIC_RELAXED, __HIP_MEMORY_SCOPE_AGENT); }
__device__ __forceinline__ unsigned xb_xcc_id() { return (unsigned)__builtin_amdgcn_s_getreg((3 << 11) | 20) & 0xFu; }
#define XB_SPIN(cond, bar) do { unsigned _sp = 0; while (cond) { __builtin_amdgcn_s_sleep(1); \
    if ((++_sp & 255u) == 0u) { if (xb_ld(&(bar)[XB_TMO])) break; if (_sp > XB_SPIN_CAP) { atomicAdd(&(bar)[XB_TMO], 1u); break; } } } } while (0)
struct XcdBarrier { unsigned* bar; unsigned x; volatile LAS unsigned* st; };
__device__ __forceinline__ XcdBarrier xcd_barrier_post(unsigned* bar, volatile LAS unsigned* st) {
    XcdBarrier b; b.bar = bar; b.x = xb_xcc_id(); b.st = st;
    if (threadIdx.x == 0) (void)xb_add(&bar[XB_XCNT(b.x)], 1u);
    return b;
}
__device__ __forceinline__ void xcd_barrier_complete(unsigned* bar, unsigned x, unsigned& nloc, unsigned& nx) {
    const unsigned G = gridDim.x * gridDim.y * gridDim.z;
    unsigned sum, cnt, mine, sp = 0u;
    for (;;) {
        sum = 0u; cnt = 0u; mine = 0u;
#pragma unroll
        for (unsigned j = 0; j < 16; ++j) { const unsigned c = xb_ld(&bar[XB_XCNT(j)]); sum += c; cnt += (c > 0u) ? 1u : 0u; mine = (j == x) ? c : mine; }
        if (sum == G) break;
        __builtin_amdgcn_s_sleep(1);
        if ((++sp & 255u) == 0u) { if (xb_ld(&bar[XB_TMO])) break; if (sp > XB_SPIN_CAP) { atomicAdd(&bar[XB_TMO], 1u); break; } }
    }
    nloc = mine > 0u ? mine : 1u; nx = cnt > 0u ? cnt : 1u;
}
__device__ __forceinline__ void xcd_barrier(const XcdBarrier& b) {
    asm volatile("s_waitcnt vmcnt(0)" ::: "memory");
    __syncthreads();
    if (threadIdx.x == 0) {
        unsigned* bar = b.bar;
        __builtin_amdgcn_s_waitcnt(0);
        unsigned nloc = b.st[0], nx = b.st[1];
        if (nloc == 0u) { xcd_barrier_complete(bar, b.x, nloc, nx); b.st[0] = nloc; b.st[1] = nx; }
        const unsigned old = xb_add(&bar[XB_XSUB(b.x)], 1u);
        const unsigned gen = old / nloc;
        if (old + 1u == (gen + 1u) * nloc) {
            __builtin_amdgcn_fence(__ATOMIC_RELEASE, "agent");
            asm volatile("s_waitcnt vmcnt(0)" ::: "memory");
            const unsigned og = xb_add(&bar[XB_TOP], 1u);
            const unsigned tg = og / nx;
            if (og + 1u == (tg + 1u) * nx) xb_add(&bar[XB_TOPGEN], 1u);
            else XB_SPIN(xb_ld(&bar[XB_TOPGEN]) == tg, bar);
            __builtin_amdgcn_fence(__ATOMIC_ACQUIRE, "agent");
            xb_add(&bar[XB_XGEN(b.x)], 1u);
            asm volatile("s_waitcnt vmcnt(0)" ::: "memory");
        } else {
            XB_SPIN(xb_ld(&bar[XB_XGEN(b.x)]) == gen, bar);
            __builtin_amdgcn_fence(__ATOMIC_ACQUIRE, "agent");
            asm volatile("s_waitcnt vmcnt(0)" ::: "memory");
        }
    }
    __syncthreads();
}

struct Args { const float* in[16]; float* out; unsigned char* ws; int ph_lo, ph_hi; };

template <bool SC>
__device__ __forceinline__ void tr_item(const float* src, int ld, bf16* dst, int K, LAS float* scr, int lane, const float* gk = nullptr) {
#pragma unroll 16
    for (int i = 0; i < 32; ++i) { const int kk = 2 * i + (lane >> 5); scr[kk * 33 + (lane & 31)] = __builtin_nontemporal_load(src + (size_t)kk * ld + (lane & 31)); }
    LDS_WAIT(); asm volatile("" ::: "memory");
    const int c = lane & 7;
    f32x4 g0 = {1.f, 1.f, 1.f, 1.f}, g1 = g0;
    if (SC) { g0 = *(const f32x4*)(gk + 8 * c); g1 = *(const f32x4*)(gk + 8 * c + 4); }
#pragma unroll
    for (int j = 0; j < 4; ++j) { const int n = (lane >> 3) + 8 * j; const LAS float* s = scr + (8 * c) * 33 + n;
        u32x4 o;
        if (SC) { o.x = pk2(s[0 * 33] * g0.x, s[1 * 33] * g0.y); o.y = pk2(s[2 * 33] * g0.z, s[3 * 33] * g0.w); o.z = pk2(s[4 * 33] * g1.x, s[5 * 33] * g1.y); o.w = pk2(s[6 * 33] * g1.z, s[7 * 33] * g1.w); }
        else { o.x = pk2(s[0 * 33], s[1 * 33]); o.y = pk2(s[2 * 33], s[3 * 33]); o.z = pk2(s[4 * 33], s[5 * 33]); o.w = pk2(s[6 * 33], s[7 * 33]); }
        __builtin_nontemporal_store(o, (GAS u32x4*)(dst + (size_t)n * K + 8 * c)); }
    LDS_WAIT(); asm volatile("" ::: "memory");
}
__device__ __forceinline__ float wave_reduce16(const float (&p)[16], int lane) {
    float a[8], b[4], c[2], d;
    { const bool hi = lane & 32;
#pragma unroll
      for (int i = 0; i < 8; ++i) { const float mine = hi ? p[i + 8] : p[i], theirs = hi ? p[i] : p[i + 8]; a[i] = mine + __shfl_xor(theirs, 32); } }
    { const bool hi = lane & 16;
#pragma unroll
      for (int i = 0; i < 4; ++i) { const float mine = hi ? a[i + 4] : a[i], theirs = hi ? a[i] : a[i + 4]; b[i] = mine + __shfl_xor(theirs, 16); } }
    { const bool hi = lane & 8;
#pragma unroll
      for (int i = 0; i < 2; ++i) { const float mine = hi ? b[i + 2] : b[i], theirs = hi ? b[i] : b[i + 2]; c[i] = mine + __shfl_xor(theirs, 8); } }
    { const bool hi = lane & 4; const float mine = hi ? c[1] : c[0], theirs = hi ? c[0] : c[1]; d = mine + __shfl_xor(theirs, 4); }
    d += __shfl_xor(d, 1); d += __shfl_xor(d, 2);
    return d;
}
__device__ __forceinline__ void p0_prologue(const Args& a, LAS unsigned char* lds, int vcu, int G) {
    const int tid = threadIdx.x, lane = tid & 63, wave = __builtin_amdgcn_readfirstlane(tid >> 6);
    unsigned char* ws = a.ws;
    const float* w_in = a.in[2]; const float* w_out = a.in[6]; const float* ew1 = a.in[12]; const float* ew3 = a.in[13]; const float* ew2 = a.in[14];
    bf16* WinT = (bf16*)(ws + WS_WIN); bf16* WoutT = (bf16*)(ws + WS_WOUT); bf16* W13T = (bf16*)(ws + WS_W13); bf16* W2T = (bf16*)(ws + WS_W2);
    const int gw = vcu * NWAVES + wave, NGW = G * NWAVES;
    {
        LAS float* wl = (LAS float*)(lds + 67584);
        for (int k = tid; k < D; k += NTHREADS) { const int slot = ((k & 3) + 4 * (k >> 8)) * 64 + ((k >> 2) & 63); const float* src = w_in + (size_t)k * INC + GLR_SRC;
#pragma unroll
            for (int q = 0; q < 4; ++q) *(LAS f32x4*)(wl + slot * 20 + 4 * q) = *(const f32x4*)(src + 4 * q); }
    }
    __syncthreads();
    {
        const float* x = a.in[0]; const float* g1 = a.in[1]; bf16* N1 = (bf16*)(ws + WS_N1); float* GLR = (float*)(ws + WS_GLR);
        const LAS float* wl = (const LAS float*)(lds + 67584);
        f32x4 g[4];
#pragma unroll
        for (int j = 0; j < 4; ++j) g[j] = ((const f32x4*)g1)[lane + 64 * j];
        f32x4 nv[4];
        if (gw < M) {
#pragma unroll
            for (int j = 0; j < 4; ++j) nv[j] = __builtin_nontemporal_load((const f32x4*)(x + (size_t)gw * D) + lane + 64 * j); }
#pragma unroll 1
        for (int m = gw; m < M; m += NGW) {
            f32x4 v[4]; float s = 0.f;
#pragma unroll
            for (int j = 0; j < 4; ++j) v[j] = nv[j];
            if (m + NGW < M) {
#pragma unroll
                for (int j = 0; j < 4; ++j) nv[j] = __builtin_nontemporal_load((const f32x4*)(x + (size_t)(m + NGW) * D) + lane + 64 * j); }
#pragma unroll
            for (int j = 0; j < 4; ++j) { s += (v[j].x * v[j].x + v[j].y * v[j].y) + (v[j].z * v[j].z + v[j].w * v[j].w); }
            const float rstd = rsqrtf(wave_sum(s) * (1.f / D) + EPS);
            GAS u32x2* o8 = (GAS u32x2*)(N1 + (size_t)m * D) + lane;
            float p[16];
#pragma unroll
            for (int r = 0; r < 16; ++r) p[r] = 0.f;
#pragma unroll
            for (int j = 0; j < 4; ++j) { v[j] = v[j] * rstd * g[j]; u32x2 w; w.x = pk2(v[j].x, v[j].y); w.y = pk2(v[j].z, v[j].w); o8[64 * j] = w;
#pragma unroll
                for (int jj = 0; jj < 4; ++jj) { const LAS float* wr = wl + ((jj + 4 * j) * 64 + lane) * 20; const float xv = v[j][jj];
#pragma unroll
                    for (int q = 0; q < 4; ++q) { const f32x4 wv = *(const LAS f32x4*)(wr + 4 * q); p[4 * q] += xv * wv.x; p[4 * q + 1] += xv * wv.y; p[4 * q + 2] += xv * wv.z; p[4 * q + 3] += xv * wv.w; }
                    if (jj & 1) asm volatile("" ::: "memory"); } }
            const float tot = wave_reduce16(p, lane);
            if ((lane & 3) == 0) GLR[(size_t)m * 16 + ((lane >> 2) & 15)] = tot;
        }
    }
    { const float* wg = a.in[8]; const float* we = a.in[10]; bf16* WRT = (bf16*)(ws + WS_WRT);
      for (int idx = gw * 64 + lane; idx < D * 36; idx += NGW * 64) { const int k = idx / 36, col = idx % 36; const float wv = (col < 4 ? wg[k * 4 + col] : we[k * 32 + col - 4]) * a.in[7][k];
          const bf16 hi = f2bf(wv), lo = f2bf(wv - bf2f(hi)); const int o = ((((k >> 5) * 2) * 36 + col) * 4 + ((k >> 3) & 3)) * 8 + (k & 7); WRT[o] = hi; WRT[o + 36 * 4 * 8] = lo; } }
    {
        LAS float* scr = (LAS float*)(lds + wave * 8448);
        constexpr int I_IN = 16 * 96, I_OUT = 16 * 32, NITEMS = I_IN + I_OUT;
        for (int it = gw; it < NITEMS; it += NGW) {
            int r = it;
            if (r < I_IN) { const int kb = r / 96, n0 = 32 * (r % 96); tr_item<false>(w_in + (size_t)(64 * kb) * INC + (n0 < 1536 ? n0 : n0 + 16), INC, WinT + (size_t)n0 * D + 64 * kb, D, scr, lane); continue; } r -= I_IN;
            { const int kb = r / 32, n0 = 32 * (r % 32); tr_item<false>(w_out + (size_t)(64 * kb) * D + n0, D, WoutT + (size_t)n0 * D + 64 * kb, D, scr, lane); }
        }
    }
}
__device__ __forceinline__ void p0_expert_items(const Args& a, LAS unsigned char* lds, int first, int stride, int end) {
    const int lane = threadIdx.x & 63, wave = __builtin_amdgcn_readfirstlane(threadIdx.x >> 6);
    const float* ew1 = a.in[12]; const float* ew3 = a.in[13]; const float* ew2 = a.in[14];
    bf16* W13T = (bf16*)(a.ws + WS_W13); bf16* W2T = (bf16*)(a.ws + WS_W2);
    LAS float* scr = (LAS float*)(lds + wave * 8448);
    constexpr int I_13 = NE * 16 * 32;
    for (int it = first; it < end; it += stride) {
        int r = it;
        if (r < I_13) { const int e = r / 512, q = r % 512, kb = q / 32, n0 = 32 * (q % 32); const float* w = ((n0 >> 7) & 1) ? ew3 : ew1;
            tr_item<true>(w + ((size_t)e * D + 64 * kb) * FF + 128 * (n0 >> 8) + (n0 & 127), FF, W13T + (size_t)e * D * D + (size_t)n0 * D + 64 * kb, D, scr, lane, a.in[7] + 64 * kb); continue; } r -= I_13;
        { const int e = r / 256, q = r % 256, kb = q / 32, n0 = 32 * (q % 32);
            tr_item<false>(ew2 + ((size_t)e * FF + 64 * kb) * D + n0, D, W2T + (size_t)e * D * FF + (size_t)n0 * FF + 64 * kb, FF, scr, lane); }
    }
}
__device__ __forceinline__ void p8_final(const Args& a, int vcu, int G, float* dst) {
    const int tid = threadIdx.x, lane = tid & 63, wave = __builtin_amdgcn_readfirstlane(tid >> 6);
    const int gw = vcu * NWAVES + wave, NGW = G * NWAVES;
    const bf16* Y = (const bf16*)(a.ws + WS_Y); float* out = a.out; const float* gf = a.in[15];
    f32x4 g[4];
#pragma unroll
    for (int j = 0; j < 4; ++j) g[j] = ((const f32x4*)gf)[lane + 64 * j];
#pragma unroll 1
    for (int m = gw; m < M; m += NGW) {
        const u32x2* hr = (const u32x2*)((const bf16*)(a.ws + WS_N2) + (size_t)m * D) + lane;
        const u32x2* y0 = (const u32x2*)(Y + (size_t)(2 * m) * D) + lane; const u32x2* y1 = y0 + D / 4;
        f32x4 v[4]; float s = 0.f;
#pragma unroll
        for (int j = 0; j < 4; ++j) { const u32x2 tv = __builtin_nontemporal_load(hr + 64 * j), p = __builtin_nontemporal_load(y0 + 64 * j), q = __builtin_nontemporal_load(y1 + 64 * j);
            v[j].x = __uint_as_float(tv.x << 16); v[j].y = __uint_as_float(tv.x & 0xffff0000u); v[j].z = __uint_as_float(tv.y << 16); v[j].w = __uint_as_float(tv.y & 0xffff0000u);
            v[j].x += __uint_as_float(p.x << 16) + __uint_as_float(q.x << 16); v[j].y += __uint_as_float(p.x & 0xffff0000u) + __uint_as_float(q.x & 0xffff0000u);
            v[j].z += __uint_as_float(p.y << 16) + __uint_as_float(q.y << 16); v[j].w += __uint_as_float(p.y & 0xffff0000u) + __uint_as_float(q.y & 0xffff0000u);
            s += (v[j].x * v[j].x + v[j].y * v[j].y) + (v[j].z * v[j].z + v[j].w * v[j].w); }
        const float rstd = rsqrtf(wave_sum(s) * (1.f / D) + EPS);
#pragma unroll
        for (int j = 0; j < 4; ++j) __builtin_nontemporal_store(v[j] * rstd * g[j], (f32x4*)(dst + (size_t)m * D) + lane + 64 * j);
    }
}

constexpr int LDS_PB = LDSCTL_OFF + 128;
constexpr int LDS_CNT = LDSCTL_OFF + 384;
constexpr int LDS_LCNT = 147456, LDS_LBASE = 147584, LDS_REC = 147712, REC_ITERS = 4;
constexpr int LDS_REX = 149760, REX_BYTES = 3200;
constexpr int CNT_STRIDE = 64;
__device__ __forceinline__ void p5_router(const Args& a, LAS unsigned char* lds, int vcu, int G) {
    const int tid = threadIdx.x, lane = tid & 63, wave = __builtin_amdgcn_readfirstlane(tid >> 6), fr = lane & 15, fq = lane >> 4, pr = wave >> 1, half = wave & 1;
    unsigned char* ws = a.ws;
    const float* bgp = a.in[9]; const float* be = a.in[11];
    const bf16* N2 = (const bf16*)(ws + WS_N2); float* RSTD = (float*)(ws + WS_RSTD); Route* ROUTE = (Route*)(ws + WS_ROUTE); int* LIST = (int*)(ws + WS_LIST);
    unsigned* cnt = (unsigned*)(ws + WS_CTL) + CW_CNT;
    { const u32x4* src = (const u32x4*)(ws + WS_WRT); LAS u32x4* dst = (LAS u32x4*)lds;
      for (int i = tid; i < 147456 / 16; i += NTHREADS) dst[i] = src[i]; }
    if (tid < NE) ((LAS unsigned*)(lds + LDS_LCNT))[tid] = 0u;
    __syncthreads();
    LAS unsigned* lcnt = (LAS unsigned*)(lds + LDS_LCNT); LAS unsigned* lbase = (LAS unsigned*)(lds + LDS_LBASE); LAS unsigned* rec = (LAS unsigned*)(lds + LDS_REC) + pr * (REC_ITERS * 32);
    LAS unsigned char* ex = lds + LDS_REX + pr * REX_BYTES; LAS float* lg = (LAS float*)ex;
    const int niter = (M / 16 + G * 4 - 1) / (G * 4);
#pragma unroll 1
    for (int it = 0; it < niter; ++it) {
        const int tile = vcu * 4 + pr + it * G * 4; const bool live = tile < M / 16;
        f32x4 acc[3]; acc[0] = (f32x4){0.f, 0.f, 0.f, 0.f}; acc[1] = acc[0]; acc[2] = acc[0]; float ssq = 0.f;
        if (live) {
            const int row = tile * 16 + fr;
            const bf16* hr = N2 + (size_t)row * D + 8 * fq + 512 * half;
            const LAS unsigned char* tb = lds + (fr * 4 + fq) * 16 + half * 16 * (2 * 36 * 64);
            const int o2 = ((32 + (fr & 3)) * 4 + fq) * 16 - (fr * 4 + fq) * 16;
            u32x4 ta[16];
#pragma unroll
            for (int s = 0; s < 16; ++s) ta[s] = __builtin_nontemporal_load((const u32x4*)(hr + 32 * s));
#pragma unroll
            for (int s = 0; s < 16; ++s) { const u32x4 tv = ta[s];
                const float hv[8] = {__uint_as_float(tv.x << 16), __uint_as_float(tv.x & 0xffff0000u), __uint_as_float(tv.y << 16), __uint_as_float(tv.y & 0xffff0000u),
                                     __uint_as_float(tv.z << 16), __uint_as_float(tv.z & 0xffff0000u), __uint_as_float(tv.w << 16), __uint_as_float(tv.w & 0xffff0000u)};
#pragma unroll
                for (int j = 0; j < 8; ++j) ssq += hv[j] * hv[j];
                const bf16x8 ah = __builtin_bit_cast(bf16x8, tv);
                const LAS unsigned char* th = tb + s * (2 * 36 * 64); const LAS unsigned char* tl = th + 36 * 64;
#pragma unroll
                for (int ct = 0; ct < 3; ++ct) { const int o = ct < 2 ? ct * 1024 : o2;
                    const bf16x8 bh = *(const LAS bf16x8*)(th + o), bl = *(const LAS bf16x8*)(tl + o);
                    acc[ct] = __builtin_amdgcn_mfma_f32_16x16x32_bf16(ah, bh, acc[ct], 0, 0, 0);
                    acc[ct] = __builtin_amdgcn_mfma_f32_16x16x32_bf16(ah, bl, acc[ct], 0, 0, 0); }
            }
            ssq += __shfl_xor(ssq, 16); ssq += __shfl_xor(ssq, 32);
            if (half) {
#pragma unroll
                for (int ct = 0; ct < 3; ++ct) *(LAS f32x4*)(ex + (ct * 64 + lane) * 16) = acc[ct];
                if (lane < 16) *(LAS float*)(ex + 3072 + lane * 4) = ssq; }
        }
        __syncthreads();
        if (live && !half) {
#pragma unroll
            for (int ct = 0; ct < 3; ++ct) acc[ct] += *(const LAS f32x4*)(ex + (ct * 64 + lane) * 16);
            ssq += *(const LAS float*)(ex + 3072 + fr * 4);
            const float rstd = rsqrtf(ssq * (1.f / D) + EPS);
            LDS_WAIT(); asm volatile("" ::: "memory");
#pragma unroll
            for (int ct = 0; ct < 3; ++ct)
#pragma unroll
                for (int r = 0; r < 4; ++r) { const int col = 16 * ct + fr; if (col < 36) lg[(4 * fq + r) * 36 + col] = acc[ct][r]; }
            LDS_WAIT(); asm volatile("" ::: "memory");
            if (lane < 16) {
                const LAS float* l = lg + 36 * lane; const int rw = tile * 16 + lane;
                int gi = 0; float gmax = l[0] * rstd + bgp[0];
                for (int c = 1; c < 4; ++c) { const float v = l[c] * rstd + bgp[c]; if (v > gmax) { gmax = v; gi = c; } }
                float den = 0.f; for (int c = 0; c < 4; ++c) den += __expf(l[c] * rstd + bgp[c] - gmax);
                const float gprob = 1.f / den;
                float b0 = -INFINITY, b1 = -INFINITY; int i0 = 0, i1 = 0;
                for (int c = 0; c < 8; ++c) { const float v = l[4 + gi * 8 + c] * rstd + be[gi * 8 + c]; if (v > b0) { b1 = b0; i1 = i0; b0 = v; i0 = c; } else if (v > b1) { b1 = v; i1 = c; } }
                const float e1x = __expf(b1 - b0); const float w0 = gprob / (1.f + e1x), w1 = gprob * e1x / (1.f + e1x);
                Route r; r.e0 = gi * 8 + i0; r.e1 = gi * 8 + i1; r.w0 = w0; r.w1 = w1; ROUTE[rw] = r; RSTD[rw] = rstd;
                const unsigned q0 = __hip_atomic_fetch_add(lcnt + r.e0, 1u, __ATOMIC_RELAXED, __HIP_MEMORY_SCOPE_WORKGROUP), q1 = __hip_atomic_fetch_add(lcnt + r.e1, 1u, __ATOMIC_RELAXED, __HIP_MEMORY_SCOPE_WORKGROUP);
                if (it < REC_ITERS) { rec[it * 32 + lane * 2] = ((unsigned)r.e0 << 16) | q0; rec[it * 32 + lane * 2 + 1] = ((unsigned)r.e1 << 16) | q1; }
            }
        }
        __syncthreads();
    }
    if (tid < NE) lbase[tid] = atomicAdd(&cnt[tid * CNT_STRIDE], lcnt[tid]);
    __syncthreads();
    if (!half && lane < 16) {
#pragma unroll 1
        for (int it = 0; it < niter && it < REC_ITERS; ++it) { const int tile = vcu * 4 + pr + it * G * 4; if (tile >= M / 16) break; const int rw = tile * 16 + lane;
            const Route rtw = ROUTE[rw]; const float rsw = RSTD[rw];
#pragma unroll
            for (int j = 0; j < 2; ++j) { const unsigned rc = rec[it * 32 + lane * 2 + j]; const int e = (int)(rc >> 16), idx = e * LIST_CAP + (int)(lbase[e] + (rc & 0xffffu));
                LIST[idx] = rw * 2 + j; ((float*)(ws + WS_LRS))[idx] = rsw; ((float*)(ws + WS_LGW))[idx] = j ? rtw.w1 : rtw.w0; } } }
}
namespace pg8 {
struct MoeOrder {
    const LAS int* pb; const LAS int* pba; const LAS int* cn; const int* list; const char* A; const char* W; int K, nN, G, c, gather; size_t wstride;
    __device__ __forceinline__ bool next(int i, Unit& u) const {
        const int L = i * G + c, NB = pb[NE]; if (L >= NB * nN) return false;
        const int rb = L / nN; u.pn = L % nN;
        int e = 0;
#pragma unroll
        for (int s = 16; s >= 1; s >>= 1) if (pb[e + s] <= rb) e += s;
        u.e = e; u.pm = rb - pb[e]; const int left = cn[e] - 256 * u.pm; u.nrows = left < 256 ? left : 256; return true;
    }
    __device__ __forceinline__ void a_off(const Unit& u, const int (&R)[2], const int (&C)[2], unsigned (&off)[2][2]) const {
#pragma unroll
        for (int h = 0; h < 2; ++h)
#pragma unroll
            for (int i = 0; i < 2; ++i) { const int r = h * HALF + R[i];
                if (gather) { const int tok = r < u.nrows ? (list[u.e * LIST_CAP + 256 * u.pm + r] >> 1) : 0; off[h][i] = (unsigned)((tok * K + C[i]) * 2); }
                else off[h][i] = (unsigned)(((256 * (pba[u.e] + u.pm) + r) * K + C[i]) * 2); }
    }
    __device__ __forceinline__ const char* a_base() const { return A; }
    __device__ __forceinline__ const char* b_base(const Unit& u) const { return W + (size_t)u.e * wstride + (size_t)u.pn * BM * K * 2; }
};
struct EpiMoeUp {
    static constexpr bool PERM = true;
    bf16* HID; const float* lrs; const float* lgw; const LAS int* pba;
    __device__ __forceinline__ void operator()(const f32x4 (&acc)[2][2][4][2], const Unit& u, int wr, int wc, int fr, int fq) const {
        const int prow0 = 256 * (pba[u.e] + u.pm);
#pragma unroll
        for (int ai = 0; ai < 2; ++ai)
#pragma unroll
            for (int m = 0; m < 4; ++m) { const int r = ai * HALF + wr * 64 + m * 16 + fr;
                const int li = u.e * LIST_CAP + 256 * u.pm + (r < u.nrows ? r : 0); const float rs = lrs[li], gw = lgw[li];
                float hv[8];
#pragma unroll
                for (int n = 0; n < 2; ++n)
#pragma unroll
                    for (int q = 0; q < 4; ++q) { const float x = acc[ai][0][m][n][q] * rs, y = acc[ai][1][m][n][q] * rs; hv[4 * n + q] = x * __builtin_amdgcn_rcpf(1.f + __expf(-x)) * (y * gw); }
                u32x4 w; w.x = cvt_pk_bf16(hv[0], hv[1]); w.y = cvt_pk_bf16(hv[2], hv[3]); w.z = cvt_pk_bf16(hv[4], hv[5]); w.w = cvt_pk_bf16(hv[6], hv[7]);
                *(u32x4*)(HID + (size_t)(prow0 + r) * FF + 128 * u.pn + 32 * wc + 8 * fq) = w; }
    }
};
struct EpiMoeDown {
    static constexpr bool PERM = true;
    bf16* Y; const int* list;
    __device__ __forceinline__ void operator()(const f32x4 (&acc)[2][2][4][2], const Unit& u, int wr, int wc, int fr, int fq) const {
#pragma unroll
        for (int ai = 0; ai < 2; ++ai)
#pragma unroll
            for (int m = 0; m < 4; ++m) { const int r = ai * HALF + wr * 64 + m * 16 + fr;
                if (r < u.nrows) { const int slot = list[u.e * LIST_CAP + 256 * u.pm + r];
                    bf16* rowp = Y + (size_t)slot * D + u.pn * BM + wc * 32 + 8 * fq;
#pragma unroll
                    for (int bj = 0; bj < 2; ++bj) { const f32x4 v0 = acc[ai][bj][m][0], v1 = acc[ai][bj][m][1];
                        u32x4 o; o.x = cvt_pk_bf16(v0[0], v0[1]); o.y = cvt_pk_bf16(v0[2], v0[3]); o.z = cvt_pk_bf16(v1[0], v1[1]); o.w = cvt_pk_bf16(v1[2], v1[3]);
                        pg8::st16_wt(rowp + bj * HALF, o); } } }
    }
};
}
constexpr int LDS_PBA = LDSCTL_OFF + 512, LDS_PTR = LDSCTL_OFF + 656;
__device__ __forceinline__ void moe_prefix(const Args& a, LAS unsigned char* lds, int G) {
    const unsigned* cnt = (const unsigned*)(a.ws + WS_CTL) + CW_CNT;
    LAS int* pb = (LAS int*)(lds + LDS_PB); LAS int* cn = (LAS int*)(lds + LDS_CNT); LAS int* pba = (LAS int*)(lds + LDS_PBA); LAS int* ptr = (LAS int*)(lds + LDS_PTR);
    __syncthreads();
    if (threadIdx.x < 64) {
        const int lane = threadIdx.x, e = lane & 31; const int c = (int)cnt[e * CNT_STRIDE];
        const int nf = c >> 8, tail = c & 255;
        int nbf = nf;
#pragma unroll
        for (int o = 1; o < 32; o <<= 1) nbf += __shfl_xor(nbf, o);
        const int cap = ((4 * nbf + G - 1) / G) * G / 4, x = cap - nbf;
        int rank = 0;
#pragma unroll 1
        for (int j = 0; j < 32; ++j) { const int tj = __shfl(tail, j); rank += (tj > tail || (tj == tail && j < e)) ? 1 : 0; }
        const int istile = (tail > 0 && rank < x) ? 1 : 0;
        const int nbt = nf + istile, nba = (c + 255) >> 8, ntr = (!istile && tail > 0) ? ((tail + 31) >> 5) : 0;
        int s1 = nbt, s2 = nba, s3 = ntr;
#pragma unroll
        for (int o = 1; o < 32; o <<= 1) { const int t1 = __shfl_up(s1, o), t2 = __shfl_up(s2, o), t3 = __shfl_up(s3, o); if (e >= o) { s1 += t1; s2 += t2; s3 += t3; } }
        if (lane < 32) { cn[e] = c; pb[e + 1] = s1; pba[e + 1] = s2; ptr[e + 1] = s3; if (e == 0) { pb[0] = 0; pba[0] = 0; ptr[0] = 0; } }
    }
    __syncthreads();
}
template <int NJ> __device__ __forceinline__ void wave_mm_tail(const bf16* a0, const bf16* a1, const bf16* b0, size_t bstride16, int K, f32x4 (&acc)[2][NJ]) {
    const int fq = (threadIdx.x & 63) >> 4;
#pragma unroll 2
    for (int k0 = 0; k0 < K; k0 += 32) {
        const bf16x8 fa0 = *(const bf16x8*)(a0 + k0 + 8 * fq), fa1 = *(const bf16x8*)(a1 + k0 + 8 * fq);
#pragma unroll
        for (int j = 0; j < NJ; ++j) { const bf16x8 fb = *(const bf16x8*)(b0 + j * bstride16 + k0 + 8 * fq);
            acc[0][j] = __builtin_amdgcn_mfma_f32_16x16x32_bf16(fa0, fb, acc[0][j], 0, 0, 0); acc[1][j] = __builtin_amdgcn_mfma_f32_16x16x32_bf16(fa1, fb, acc[1][j], 0, 0, 0); }
    }
}
template <bool UP> __device__ __forceinline__ void moe_tail_tasks(const Args& a, LAS unsigned char* lds, int c_, int G) {
    const LAS int* pb = (const LAS int*)(lds + LDS_PB); const LAS int* cn = (const LAS int*)(lds + LDS_CNT); const LAS int* pba = (const LAS int*)(lds + LDS_PBA); const LAS int* ptr = (const LAS int*)(lds + LDS_PTR);
    const int tid = threadIdx.x, lane = tid & 63, wave = __builtin_amdgcn_readfirstlane(tid >> 6), fr = lane & 15;
    constexpr int NJ = UP ? 4 : 8, CW = 16 * NJ, NCT = (UP ? FF : D) / CW, K = UP ? D : FF, KW = K / NWAVES, NTILE = (UP ? 2 : 1) * 2 * NJ;
    const int NT = ptr[NE] * NCT;
    const int* list = (const int*)(a.ws + WS_LIST); const bf16* N2 = (const bf16*)(a.ws + WS_N2); bf16* HID = (bf16*)(a.ws + WS_HID);
    LAS f32x4* P = (LAS f32x4*)lds;
#pragma unroll 1
    for (int tt = c_; tt < NT; tt += G) {
        const int rt = tt / NCT, ct = tt % NCT;
        int e = 0;
#pragma unroll
        for (int s = 16; s >= 1; s >>= 1) if (ptr[e + s] <= rt) e += s;
        const int c = cn[e], r0 = 256 * (pb[e + 1] - pb[e]) + 32 * (rt - ptr[e]), prow = 256 * pba[e];
        const int p0 = r0 + fr, p1 = r0 + 16 + fr, k0 = wave * KW;
        if (UP) {
            const int t0 = p0 < c ? (list[e * LIST_CAP + p0] >> 1) : 0, t1 = p1 < c ? (list[e * LIST_CAP + p1] >> 1) : 0;
            const int j0 = ct * CW + fr, ra = 256 * (j0 >> 7) + (j0 & 127);
            const bf16* W = (const bf16*)(a.ws + WS_W13) + (size_t)e * D * D + k0;
            f32x4 accA[2][NJ] = {}, accB[2][NJ] = {};
            wave_mm_tail<NJ>(N2 + (size_t)t0 * D + k0, N2 + (size_t)t1 * D + k0, W + (size_t)ra * D, (size_t)16 * D, KW, accA);
            wave_mm_tail<NJ>(N2 + (size_t)t0 * D + k0, N2 + (size_t)t1 * D + k0, W + (size_t)(ra + 128) * D, (size_t)16 * D, KW, accB);
#pragma unroll
            for (int i = 0; i < 2; ++i)
#pragma unroll
                for (int j = 0; j < NJ; ++j) { P[(wave * NTILE + i * NJ + j) * 64 + lane] = accA[i][j]; P[(wave * NTILE + 2 * NJ + i * NJ + j) * 64 + lane] = accB[i][j]; }
        } else {
            const int q0 = p0 < c ? p0 : 0, q1 = p1 < c ? p1 : 0, c0 = ct * CW;
            const bf16* W = (const bf16*)(a.ws + WS_W2) + (size_t)e * D * FF + k0;
            f32x4 acc[2][NJ] = {};
            wave_mm_tail<NJ>(HID + (size_t)(prow + q0) * FF + k0, HID + (size_t)(prow + q1) * FF + k0, W + (size_t)(c0 + fr) * FF, (size_t)16 * FF, KW, acc);
#pragma unroll
            for (int i = 0; i < 2; ++i)
#pragma unroll
                for (int j = 0; j < NJ; ++j) P[(wave * NTILE + i * NJ + j) * 64 + lane] = acc[i][j];
        }
        __syncthreads();
        {
            const int ln = tid & 63, g = tid >> 6, frr = ln & 15, fqq = ln >> 4;
#pragma unroll
            for (int q = 0; q < (UP ? 1 : 2); ++q) { const int ij = UP ? g : 2 * g + q, i = ij / NJ, j = ij % NJ;
                f32x4 sa = (f32x4){0.f, 0.f, 0.f, 0.f}, sb = sa;
#pragma unroll
                for (int w = 0; w < NWAVES; ++w) { sa += P[(w * NTILE + ij) * 64 + ln]; if (UP) sb += P[(w * NTILE + 2 * NJ + ij) * 64 + ln]; }
#pragma unroll
                for (int r = 0; r < 4; ++r) { const int pos = r0 + 16 * i + 4 * fqq + r;
                    if (pos < c) {
                        const int slot = list[e * LIST_CAP + pos];
                        if (UP) { const float rs = ((const float*)(a.ws + WS_LRS))[e * LIST_CAP + pos], w = ((const float*)(a.ws + WS_LGW))[e * LIST_CAP + pos]; const float x = sa[r] * rs, y = sb[r] * rs;
                            HID[(size_t)(prow + pos) * FF + ct * CW + 16 * j + frr] = f2bf(x * __builtin_amdgcn_rcpf(1.f + __expf(-x)) * (y * w)); }
                        else ((bf16*)(a.ws + WS_Y))[(size_t)slot * D + ct * CW + 16 * j + frr] = f2bf(sa[r]); } } }
        }
        __syncthreads();
    }
}
typedef short v4i16_t __attribute__((ext_vector_type(4)));
typedef float f32x16 __attribute__((ext_vector_type(16)));
template <int RB> __device__ __forceinline__ int img_off(int row, int chunk) { return row * RB + ((chunk ^ (row & 7)) << 4); }
template <int RB> __device__ __forceinline__ bf16x8 frag_row(const LAS unsigned char* img, int row0, int k0, int lane) {
    return *(const LAS bf16x8*)(img + img_off<RB>(row0 + (lane & 31), (k0 >> 3) + (lane >> 5)));
}
template <int RB, bool PERMK> __device__ __forceinline__ bf16x8 frag_col(const LAS unsigned char* img, int k0, int n0, int lane) {
    const int h = lane >> 5, ch = (lane >> 4) & 1, q = (lane & 15) >> 2, p = lane & 3;
    const int ra = k0 + (PERMK ? 4 * h : 8 * h) + q, rb = ra + (PERMK ? 8 : 4);
    const int chunk = (n0 >> 3) + 2 * ch + (p >> 1), sub = (p & 1) * 8;
    const v4i16_t lo = __builtin_amdgcn_ds_read_tr16_b64_v4i16((LAS v4i16_t*)(img + img_off<RB>(ra, chunk) + sub));
    const v4i16_t hi = __builtin_amdgcn_ds_read_tr16_b64_v4i16((LAS v4i16_t*)(img + img_off<RB>(rb, chunk) + sub));
    return (bf16x8){lo[0], lo[1], lo[2], lo[3], hi[0], hi[1], hi[2], hi[3]};
}
__device__ __forceinline__ int crow(int r, int h) { return (r & 3) + 8 * (r >> 2) + 4 * h; }
__device__ __forceinline__ bf16x8 pack8(const f32x16& x, int s) {
    u32x4 w; w.x = pg8::cvt_pk_bf16(x[8 * s], x[8 * s + 1]); w.y = pg8::cvt_pk_bf16(x[8 * s + 2], x[8 * s + 3]); w.z = pg8::cvt_pk_bf16(x[8 * s + 4], x[8 * s + 5]); w.w = pg8::cvt_pk_bf16(x[8 * s + 6], x[8 * s + 7]);
    return __builtin_bit_cast(bf16x8, w);
}

constexpr int ATT_UNITS = BATCH * 8 * 3 * 32;
constexpr int ATT_LK = 0, ATT_LV = 49152, ATT_STG = 98304, ATT_WS = 131072;
constexpr float ATT_C = 0.125f * 1.4426950408889634f;
struct AttU { int b, head, br, d, r, i0; };
__device__ __forceinline__ AttU attn_decode(int u) { AttU a; const int x = u & 31; a.br = (u >> 5) % 3; const int bh = (u >> 5) / 3; a.b = bh >> 3; a.head = bh & 7;
    a.d = a.br == 0 ? 1 : (a.br == 1 ? 4 : 16); const int nblk = 32 / a.d; a.r = x / nblk; a.i0 = (x % nblk) * 256; return a; }
template <int WHICH> __device__ __forceinline__ void attn_fetch(const AttU& a, const bf16* proj, u32x4 (&kv)[6]) {
    const int tid = threadIdx.x; const bf16* pb = proj + (size_t)a.b * T * NPROJ + a.head * 64 + (WHICH ? C_AV : C_AK);
#pragma unroll
    for (int it = 0; it < 6; ++it) { const int c = tid + NTHREADS * it, row = c >> 3, ch = c & 7, ki = a.i0 - 128 + row, kc = ki < 0 ? 0 : ki;
        kv[it] = *(const u32x4*)(pb + (size_t)(kc * a.d + a.r) * NPROJ + ch * 8); }
}
template <int WHICH> __device__ __forceinline__ void attn_put(const u32x4 (&kv)[6], LAS unsigned char* lds) {
    const int tid = threadIdx.x;
#pragma unroll
    for (int it = 0; it < 6; ++it) { const int c = tid + NTHREADS * it, row = c >> 3, ch = c & 7; *(LAS u32x4*)(lds + (WHICH ? ATT_LV : ATT_LK) + img_off<128>(row, ch)) = kv[it]; }
}
__device__ __forceinline__ void attn_unit(const AttU& a, const AttU& an, u32x4 (&kk)[6], u32x4 (&vv)[6], const bf16* proj, bf16* OBR, float* ML, LAS unsigned char* lds) {
    const int tid = threadIdx.x, lane = tid & 63, w = __builtin_amdgcn_readfirstlane(tid >> 6), r32 = lane & 31, h = lane >> 5;
    const int d = a.d, r = a.r, i0 = a.i0, b = a.b, head = a.head, br = a.br;
    const bf16* pb = proj + (size_t)b * T * NPROJ + head * 64;
    bf16x8 qf[4];
    { const bf16* qp = pb + (size_t)((i0 + 32 * w + r32) * d + r) * NPROJ + C_AQ + 8 * h;
#pragma unroll
      for (int s = 0; s < 4; ++s) qf[s] = *(const bf16x8*)(qp + 16 * s); }
    attn_put<0>(kk, lds); attn_put<1>(vv, lds);
    __syncthreads();
    attn_fetch<0>(an, proj, kk);
    f32x16 S[5];
    { bf16x8 kf[2][4];
#pragma unroll
      for (int s = 0; s < 4; ++s) kf[0][s] = frag_row<128>(lds + ATT_LK, 32 * w, 16 * s, lane);
#pragma unroll
      for (int t = 0; t < 5; ++t) {
          if (t < 4) {
#pragma unroll
              for (int s = 0; s < 4; ++s) kf[(t + 1) & 1][s] = frag_row<128>(lds + ATT_LK, 32 * w + 32 * (t + 1), 16 * s, lane); }
          __builtin_amdgcn_sched_barrier(0);
          S[t] = (f32x16){};
#pragma unroll
          for (int s = 0; s < 4; ++s) S[t] = __builtin_amdgcn_mfma_f32_32x32x16_bf16(kf[t & 1][s], qf[s], S[t], 0, 0, 0);
          __builtin_amdgcn_sched_barrier(0); } }
    const int kbase = i0 + 32 * w - 128;
#pragma unroll
    for (int rr = 0; rr < 16; ++rr) { const int kr = crow(rr, h); S[0][rr] = (kr >= r32) ? S[0][rr] : -INFINITY; S[4][rr] = (kr <= r32) ? S[4][rr] : -INFINITY; }
    if (kbase < 0) {
#pragma unroll
        for (int t = 0; t < 5; ++t)
#pragma unroll
            for (int rr = 0; rr < 16; ++rr) S[t][rr] = (kbase + 32 * t + crow(rr, h)) >= 0 ? S[t][rr] : -INFINITY; }
    float mx = -INFINITY;
#pragma unroll
    for (int t = 0; t < 5; ++t)
#pragma unroll
        for (int rr = 0; rr < 16; ++rr) mx = fmaxf(mx, S[t][rr]);
    mx = fmaxf(mx, __shfl_xor(mx, 32)) * ATT_C;
    float ls = 0.f;
#pragma unroll
    for (int t = 0; t < 5; ++t)
#pragma unroll
        for (int rr = 0; rr < 16; ++rr) { const float pv = __builtin_amdgcn_exp2f(__builtin_fmaf(S[t][rr], ATT_C, -mx)); S[t][rr] = pv; ls += pv; }
    ls += __shfl_xor(ls, 32);
    bf16x8 pa[5][2];
#pragma unroll
    for (int t = 0; t < 5; ++t)
#pragma unroll
        for (int s2 = 0; s2 < 2; ++s2) pa[t][s2] = pack8(S[t], s2);
    __builtin_amdgcn_sched_barrier(0);
    attn_fetch<1>(an, proj, vv);
    __builtin_amdgcn_sched_barrier(0);
    f32x16 O[2]; O[0] = (f32x16){}; O[1] = (f32x16){};
    { bf16x8 vf[2][2];
#pragma unroll
      for (int db = 0; db < 2; ++db) vf[0][db] = frag_col<128, true>(lds + ATT_LV, 32 * w, 32 * db, lane);
#pragma unroll
      for (int i = 0; i < 10; ++i) { const int t = i >> 1, s2 = i & 1;
          if (i < 9) {
#pragma unroll
              for (int db = 0; db < 2; ++db) vf[(i + 1) & 1][db] = frag_col<128, true>(lds + ATT_LV, 32 * w + 16 * (i + 1), 32 * db, lane); }
          __builtin_amdgcn_sched_barrier(0);
#pragma unroll
          for (int db = 0; db < 2; ++db) O[db] = __builtin_amdgcn_mfma_f32_32x32x16_bf16(vf[i & 1][db], pa[t][s2], O[db], 0, 0, 0);
          __builtin_amdgcn_sched_barrier(0); } }
    { const float il = 1.f / ls;
      bf16* orow = OBR + ((size_t)br * M + (size_t)b * T + (size_t)((i0 + 32 * w + r32) * d + r)) * 512 + head * 64 + 8 * h;
#pragma unroll
      for (int db = 0; db < 2; ++db)
#pragma unroll
          for (int gp = 0; gp < 2; ++gp) {
              unsigned ax = pg8::cvt_pk_bf16(O[db][8 * gp] * il, O[db][8 * gp + 1] * il), ay = pg8::cvt_pk_bf16(O[db][8 * gp + 2] * il, O[db][8 * gp + 3] * il);
              unsigned bx2 = pg8::cvt_pk_bf16(O[db][8 * gp + 4] * il, O[db][8 * gp + 5] * il), by = pg8::cvt_pk_bf16(O[db][8 * gp + 6] * il, O[db][8 * gp + 7] * il);
              { const auto sx = __builtin_amdgcn_permlane32_swap(ax, bx2, false, false); ax = sx[0]; bx2 = sx[1]; }
              { const auto sy = __builtin_amdgcn_permlane32_swap(ay, by, false, false); ay = sy[0]; by = sy[1]; }
              *(u32x4*)(orow + 32 * db + 16 * gp) = (u32x4){ax, ay, bx2, by}; } }
    if (h == 0) { float* ml = ML + (((size_t)br * M + (size_t)b * T + (size_t)((i0 + 32 * w + r32) * d + r)) * 8 + head) * 2; ml[0] = mx; ml[1] = ls; }
    __syncthreads();
}
constexpr int ATT_SPLIT = ATT_UNITS / 2;
__device__ __forceinline__ void attn_units(int first, int stride, int end, const bf16* proj, bf16* OBR, float* ML, LAS unsigned char* lds) {
    if (first >= end) return;
    u32x4 kv[6], vv[6]; AttU cur = attn_decode(first); attn_fetch<0>(cur, proj, kv); attn_fetch<1>(cur, proj, vv);
#pragma unroll 1
    for (int u = first; u < end; u += stride) {
        const bool hn = u + stride < end; const AttU nxt = attn_decode(hn ? u + stride : u);
        attn_unit(cur, nxt, kv, vv, proj, OBR, ML, lds);
        cur = nxt;
    }
}
__device__ __forceinline__ void attn_merge_rows(const bf16* OBR, const float* ML, bf16* O, int gw, int NGW, int lane) {
    constexpr int MB = 4;
    const int head = lane >> 3;
#pragma unroll 1
    for (int m0 = gw; m0 < M; m0 += NGW * MB) {
        float mm[MB][3], ll[MB][3]; u32x4 ov[MB][3];
#pragma unroll
        for (int b = 0; b < MB; ++b) { const int m = min(m0 + b * NGW, M - 1);
#pragma unroll
            for (int br = 0; br < 3; ++br) { const float2 ml = *(const float2*)(ML + (((size_t)br * M + m) * 8 + head) * 2); mm[b][br] = ml.x; ll[b][br] = ml.y;
                ov[b][br] = __builtin_nontemporal_load((const u32x4*)(OBR + ((size_t)br * M + m) * 512 + lane * 8)); } }
#pragma unroll
        for (int b = 0; b < MB; ++b) { const int m = m0 + b * NGW;
            const float mxx = fmaxf(fmaxf(mm[b][0], mm[b][1]), mm[b][2]);
            float wgt[3], wsum = 0.f;
#pragma unroll
            for (int br = 0; br < 3; ++br) { wgt[br] = ll[b][br] * __builtin_amdgcn_exp2f(mm[b][br] - mxx); wsum += wgt[br]; }
            const float iw = 1.f / wsum; float acc[8];
#pragma unroll
            for (int e = 0; e < 8; ++e) acc[e] = 0.f;
#pragma unroll
            for (int br = 0; br < 3; ++br) { const float wb = wgt[br] * iw;
#pragma unroll
                for (int e = 0; e < 4; ++e) { const unsigned pk = ov[b][br][e]; acc[2 * e] += wb * __uint_as_float(pk << 16); acc[2 * e + 1] += wb * __uint_as_float(pk & 0xffff0000u); } }
            u32x4 o; o.x = pk2(acc[0], acc[1]); o.y = pk2(acc[2], acc[3]); o.z = pk2(acc[4], acc[5]); o.w = pk2(acc[6], acc[7]);
            if (m < M) *(u32x4*)(O + (size_t)m * D + 512 + lane * 8) = o;
        }
    }
}
constexpr int GLA_SEG = 256, GLA_NSEG = T / GLA_SEG, GLA_UNITS = BATCH * 4 * GLA_NSEG;
constexpr int GL_QP = 16384, GL_KP = 24576, GL_KPP = 32768, GL_V = 40960, GL_ST = 57344, GL_O = 73728, GL_PART = 107520, GL_GLR = 109568, GL_AL = 113664;
constexpr int GL_OLD = 132;
constexpr size_t WS_GLAS_A = WS_GLAS + 8 * MiB;
struct GLoad { f32x4 glr; u32x4 v[2]; bf16 k[8], q[8]; };
__device__ __forceinline__ float fast_logsigmoid(float z) {
    const float e = __builtin_amdgcn_exp2f(-fabsf(z) * 1.4426950408889634f);
    return fminf(z, 0.f) - __builtin_amdgcn_logf(1.f + e) * 0.6931471805599453f;
}
template <bool FULL> __device__ __forceinline__ void gla_fetch(GLoad& L, const bf16* proj, const float* glr, int b, int h, int t0) {
    const int tid = threadIdx.x, dk = tid & 63, tg = tid >> 6; const size_t row0 = (size_t)b * T + t0;
    L.glr = (f32x4){0.f, 0.f, 0.f, 0.f}; if (tid < 256) L.glr = ((const f32x4*)(glr + row0 * 16))[tid];
#pragma unroll
    for (int j = 0; j < 2; ++j) { const int c = tid + NTHREADS * j, tok = c >> 4, ch = c & 15; L.v[j] = *(const u32x4*)(proj + (row0 + tok) * NPROJ + C_GV + h * 128 + ch * 8); }
#pragma unroll
    for (int i = 0; i < 8; ++i) { const bf16* pr = proj + (row0 + tg * 8 + i) * NPROJ + h * 64 + dk; L.k[i] = pr[C_GK]; if (FULL) L.q[i] = pr[C_GQ]; }
}
template <bool FULL> __device__ __forceinline__ float gla_prep(const GLoad& L, const float (&w2r)[16], float bb, LAS unsigned char* lds) {
    const int tid = threadIdx.x, dk = tid & 63, tg = tid >> 6;
    LAS float* gl = (LAS float*)(lds + GL_GLR); LAS float* part = (LAS float*)(lds + GL_PART); LAS float* al = (LAS float*)(lds + GL_AL);
    if (tid < 256) *(LAS f32x4*)(gl + 4 * tid) = L.glr;
#pragma unroll
    for (int j = 0; j < 2; ++j) { const int c = tid + NTHREADS * j, tok = c >> 4, ch = c & 15; *(LAS u32x4*)(lds + GL_V + img_off<256>(tok, ch)) = L.v[j]; }
    __syncthreads();
    float la[8];
#pragma unroll
    for (int i = 0; i < 8; ++i) { const LAS float* g = gl + (tg * 8 + i) * 16; float z = bb;
#pragma unroll
        for (int q = 0; q < 4; ++q) { const f32x4 gv = *(const LAS f32x4*)(g + 4 * q); z += gv.x * w2r[4 * q] + gv.y * w2r[4 * q + 1] + gv.z * w2r[4 * q + 2] + gv.w * w2r[4 * q + 3]; }
        la[i] = fast_logsigmoid(z) * (1.f / 16.f); }
#pragma unroll
    for (int i = 1; i < 8; ++i) la[i] += la[i - 1];
    part[tg * 64 + dk] = la[7];
    __syncthreads();
    float offs = 0.f, glast = 0.f;
#pragma unroll
    for (int g = 0; g < 8; ++g) { const float pv = part[g * 64 + dk]; glast += pv; if (g < tg) offs += pv; }
    if (tg == 0) al[dk] = __expf(glast);
#pragma unroll
    for (int i = 0; i < 8; ++i) { const int tok = tg * 8 + i; const float G = offs + la[i];
        const float kv = bf2f(L.k[i]); const int o = img_off<128>(tok, dk >> 3) + (dk & 7) * 2;
        *(LAS bf16*)(lds + GL_KPP + o) = (bf16)pg8::cvt_pk_bf16(kv * __expf(glast - G), 0.f);
        if (FULL) { const float qv = bf2f(L.q[i]) * 0.125f; *(LAS bf16*)(lds + GL_QP + o) = (bf16)pg8::cvt_pk_bf16(qv * __expf(G), 0.f); *(LAS bf16*)(lds + GL_KP + o) = (bf16)pg8::cvt_pk_bf16(kv * __expf(-G), 0.f); } }
    return glast;
}
__device__ __forceinline__ void gla_state_update(f32x16& Sacc, LAS unsigned char* lds, int rb, int cb, int lane) {
    f32x16 U = (f32x16){};
#pragma unroll
    for (int s = 0; s < 4; ++s) U = __builtin_amdgcn_mfma_f32_32x32x16_bf16(frag_col<128, false>(lds + GL_KPP, 16 * s, 32 * rb, lane), frag_col<256, false>(lds + GL_V, 16 * s, 32 * cb, lane), U, 0, 0, 0);
    const LAS float* al = (const LAS float*)(lds + GL_AL);
#pragma unroll
    for (int r = 0; r < 16; ++r) Sacc[r] = al[32 * rb + crow(r, lane >> 5)] * Sacc[r] + U[r];
}
__device__ __forceinline__ void gla_pass1_unit(int u, const Args& a, LAS unsigned char* lds) {
    const int tid = threadIdx.x, lane = tid & 63, w = __builtin_amdgcn_readfirstlane(tid >> 6), rb = w >> 2, cb = w & 3;
    const int seg = u % GLA_NSEG, bh = u / GLA_NSEG, b = bh >> 2, h = bh & 3, dk = tid & 63;
    const bf16* proj = (const bf16*)(a.ws + WS_PROJ); const float* glr = (const float*)(a.ws + WS_GLR);
    float w2r[16];
#pragma unroll
    for (int r = 0; r < 16; ++r) w2r[r] = a.in[3][r * 256 + h * 64 + dk];
    const float bb = a.in[4][h * 64 + dk];
    f32x16 Sacc = (f32x16){}; float gsum = 0.f;
    GLoad L; gla_fetch<false>(L, proj, glr, b, h, seg * GLA_SEG);
#pragma unroll 1
    for (int c = 0; c < GLA_SEG / 64; ++c) {
        gsum += gla_prep<false>(L, w2r, bb, lds);
        if (c + 1 < GLA_SEG / 64) gla_fetch<false>(L, proj, glr, b, h, seg * GLA_SEG + (c + 1) * 64);
        __syncthreads();
        gla_state_update(Sacc, lds, rb, cb, lane);
        __syncthreads();
    }
    float* U = (float*)(a.ws + WS_GLAS) + (size_t)u * 64 * 128;
#pragma unroll
    for (int r = 0; r < 16; ++r) U[(32 * rb + crow(r, lane >> 5)) * 128 + 32 * cb + (lane & 31)] = Sacc[r];
    if (tid < 64) ((float*)(a.ws + WS_GLAS_A))[(size_t)u * 64 + dk] = __expf(gsum);
}
__device__ __forceinline__ void gla_pass2_unit(int u, const Args& a, LAS unsigned char* lds) {
    const int tid = threadIdx.x, lane = tid & 63, w = __builtin_amdgcn_readfirstlane(tid >> 6), rb = w >> 2, cb = w & 3, r32 = lane & 31, hh = lane >> 5;
    const int seg = u % GLA_NSEG, bh = u / GLA_NSEG, b = bh >> 2, h = bh & 3, dk = tid & 63;
    const bf16* proj = (const bf16*)(a.ws + WS_PROJ); const float* glr = (const float*)(a.ws + WS_GLR); bf16* Oo = (bf16*)(a.ws + WS_O);
    float w2r[16];
#pragma unroll
    for (int r = 0; r < 16; ++r) w2r[r] = a.in[3][r * 256 + h * 64 + dk];
    const float bb = a.in[4][h * 64 + dk];
    const int etok = tid >> 3, epart = tid & 7;
    float gn[16];
#pragma unroll
    for (int i = 0; i < 16; ++i) gn[i] = a.in[5][epart * 16 + i];
    f32x16 Sacc;
    { const float* Us = (const float*)(a.ws + WS_GLAS) + (size_t)u * 64 * 128;
#pragma unroll
      for (int r = 0; r < 16; ++r) Sacc[r] = Us[(32 * rb + crow(r, hh)) * 128 + 32 * cb + r32]; }
    GLoad L; gla_fetch<true>(L, proj, glr, b, h, seg * GLA_SEG);
#pragma unroll 1
    for (int c = 0; c < GLA_SEG / 64; ++c) {
        const int t0 = seg * GLA_SEG + c * 64;
#pragma unroll
        for (int g4 = 0; g4 < 4; ++g4) { u32x2 pk; pk.x = pg8::cvt_pk_bf16(Sacc[4 * g4], Sacc[4 * g4 + 1]); pk.y = pg8::cvt_pk_bf16(Sacc[4 * g4 + 2], Sacc[4 * g4 + 3]);
            *(LAS u32x2*)(lds + GL_ST + img_off<128>(32 * cb + r32, 4 * rb + g4) + 8 * hh) = pk; }
        (void)gla_prep<true>(L, w2r, bb, lds);
        if (c + 1 < GLA_SEG / 64) gla_fetch<true>(L, proj, glr, b, h, t0 + 64);
        const size_t erow = (size_t)b * T + t0 + etok;
        const u32x4* gp = (const u32x4*)(proj + erow * NPROJ + C_GR + h * 128 + epart * 16); const u32x4 g0 = gp[0], g1 = gp[1];
        __syncthreads();
        f32x16 Oa = (f32x16){};
#pragma unroll
        for (int t = 0; t < 2; ++t) if (t <= rb) {
            f32x16 X = (f32x16){};
#pragma unroll
            for (int s = 0; s < 4; ++s) X = __builtin_amdgcn_mfma_f32_32x32x16_bf16(frag_row<128>(lds + GL_KP, 32 * t, 16 * s, lane), frag_row<128>(lds + GL_QP, 32 * rb, 16 * s, lane), X, 0, 0, 0);
            if (t == rb) {
#pragma unroll
                for (int r = 0; r < 16; ++r) X[r] = crow(r, hh) <= r32 ? X[r] : 0.f; }
#pragma unroll
            for (int s2 = 0; s2 < 2; ++s2) Oa = __builtin_amdgcn_mfma_f32_32x32x16_bf16(pack8(X, s2), frag_col<256, true>(lds + GL_V, 32 * t + 16 * s2, 32 * cb, lane), Oa, 0, 0, 0);
        }
#pragma unroll
        for (int s = 0; s < 4; ++s) Oa = __builtin_amdgcn_mfma_f32_32x32x16_bf16(frag_row<128>(lds + GL_QP, 32 * rb, 16 * s, lane), frag_row<128>(lds + GL_ST, 32 * cb, 16 * s, lane), Oa, 0, 0, 0);
        gla_state_update(Sacc, lds, rb, cb, lane);
        { LAS float* ol = (LAS float*)(lds + GL_O);
#pragma unroll
          for (int r = 0; r < 16; ++r) ol[(32 * rb + crow(r, hh)) * GL_OLD + 32 * cb + r32] = Oa[r]; }
        __syncthreads();
        { const LAS float* ol = (const LAS float*)(lds + GL_O) + etok * GL_OLD + epart * 16; float ov[16]; float ss = 0.f;
#pragma unroll
          for (int q = 0; q < 4; ++q) { const f32x4 t4 = *(const LAS f32x4*)(ol + 4 * q); ov[4 * q] = t4.x; ov[4 * q + 1] = t4.y; ov[4 * q + 2] = t4.z; ov[4 * q + 3] = t4.w; ss += (t4.x * t4.x + t4.y * t4.y) + (t4.z * t4.z + t4.w * t4.w); }
          ss += __shfl_xor(ss, 1); ss += __shfl_xor(ss, 2); ss += __shfl_xor(ss, 4);
          const float rstd = rsqrtf(ss * (1.f / 128.f) + EPS);
          const size_t row = erow;
          const unsigned gw_[8] = {g0.x, g0.y, g0.z, g0.w, g1.x, g1.y, g1.z, g1.w}; float res[16];
#pragma unroll
          for (int i = 0; i < 8; ++i) { const float ga = __uint_as_float(gw_[i] << 16), gb = __uint_as_float(gw_[i] & 0xffff0000u);
              res[2 * i] = ov[2 * i] * rstd * gn[2 * i] * (ga * __builtin_amdgcn_rcpf(1.f + __expf(-ga))); res[2 * i + 1] = ov[2 * i + 1] * rstd * gn[2 * i + 1] * (gb * __builtin_amdgcn_rcpf(1.f + __expf(-gb))); }
          u32x4 o0, o1; o0.x = pk2(res[0], res[1]); o0.y = pk2(res[2], res[3]); o0.z = pk2(res[4], res[5]); o0.w = pk2(res[6], res[7]);
          o1.x = pk2(res[8], res[9]); o1.y = pk2(res[10], res[11]); o1.z = pk2(res[12], res[13]); o1.w = pk2(res[14], res[15]);
          u32x4* op = (u32x4*)(Oo + row * D + h * 128 + epart * 16); op[0] = o0; op[1] = o1; }
    }
    __syncthreads();
}
__device__ __forceinline__ void gla_scan(const Args& a, int blk) {
    if (blk >= BATCH * 4 * 16) return;
    const int bh = blk >> 4, elem = (blk & 15) * NTHREADS + threadIdx.x, dk = elem >> 7;
    float* U = (float*)(a.ws + WS_GLAS) + (size_t)bh * GLA_NSEG * 8192 + elem; const float* A = (const float*)(a.ws + WS_GLAS_A) + (size_t)bh * GLA_NSEG * 64 + dk;
    float uv[GLA_NSEG], av[GLA_NSEG];
#pragma unroll
    for (int j = 0; j < GLA_NSEG; ++j) { uv[j] = U[(size_t)j * 8192]; av[j] = A[j * 64]; }
    float S = 0.f;
#pragma unroll
    for (int j = 0; j < GLA_NSEG; ++j) { U[(size_t)j * 8192] = S; S = av[j] * S + uv[j]; }
}
__global__ void __launch_bounds__(NTHREADS, 2) fwd(Args args) {
    extern __shared__ __attribute__((aligned(16))) unsigned char lds_raw[];
    LAS unsigned char* lds = (LAS unsigned char*)lds_raw;
    const int tid = threadIdx.x;
    const int G = gridDim.x; const int bx = blockIdx.x; const int vcu = (G % 8 == 0) ? (bx % 8) * (G / 8) + bx / 8 : bx;
    unsigned char* ws = args.ws;
    unsigned* ctl = (unsigned*)(ws + WS_CTL);
    for (int u = tid; u < (LDS_BYTES - LDSCTL_OFF) / 4; u += NTHREADS) ((LAS unsigned*)(lds + LDSCTL_OFF))[u] = 0u;
    __syncthreads();
    const int lo = args.ph_lo, hi = args.ph_hi;
    XcdBarrier bar; bar.bar = ctl + CW_BAR; bar.x = 0; bar.st = nullptr;
    if (hi - lo > 1) bar = xcd_barrier_post(ctl + CW_BAR, (volatile LAS unsigned*)(lds + LDSCTL_OFF + 64));
#define IN(k) (lo <= (k) && (k) < hi)
#define SEAM(k) do { if (IN(k) && IN((k) + 1)) xcd_barrier(bar); } while (0)
    bf16* OBR = (bf16*)args.out; float* MLp = (float*)((unsigned char*)args.out + 48 * MiB);
    if (IN(0)) { p0_prologue(args, lds, vcu, G); SEAM(0); }
    if (IN(1)) {
        constexpr int NEI = NE * 16 * 32 + NE * 8 * 32;
        const int grp = (G >= 16) ? ((bx >> 3) & 1) : 0, ngrp = (G >= 16) ? 2 : 1, rank = (G >= 16) ? ((bx >> 4) * 8 + (bx & 7)) : bx, per = (G >= 16) ? G / 2 : G;
        const int wv = __builtin_amdgcn_readfirstlane(tid >> 6);
        const int e_lo = grp * (NEI / ngrp), e_hi = (grp + 1) * (NEI / ngrp);
        if (grp == 0) { p0_expert_items(args, lds, e_lo + rank * NWAVES + wv, per * NWAVES, e_hi); __syncthreads(); }
        pg8::DenseOrder S; S.init(ws + WS_N1, ws + WS_WIN, M, NPROJ, D, G, bx);
        pg8::EpiBf16 E{(bf16*)(ws + WS_PROJ), NPROJ};
        pg8::gemm_phase<pg8::EpiBf16, pg8::DenseOrder, true>(lds, D, S, E);
        if (grp == 1) { __syncthreads(); p0_expert_items(args, lds, e_lo + rank * NWAVES + wv, per * NWAVES, e_hi); }
        SEAM(1);
    }
    if (IN(2)) {
        for (int i = bx; i < GLA_UNITS; i += G) gla_pass1_unit(i, args, lds);
        SEAM(2);
    }
    if (IN(3)) {
        for (int blk = bx; blk < BATCH * 4 * 16; blk += G) gla_scan(args, blk);
        attn_units(bx, G, ATT_UNITS, (const bf16*)(ws + WS_PROJ), OBR, MLp, lds);
        SEAM(3);
    }
    if (IN(4)) {
        const bool merge_first = (bx >> 3) & 1;
        if (merge_first) attn_merge_rows((const bf16*)args.out, (const float*)((unsigned char*)args.out + 48 * MiB), (bf16*)(ws + WS_O), vcu * NWAVES + (tid >> 6), G * NWAVES, tid & 63);
        for (int u = bx; u < GLA_UNITS; u += G) gla_pass2_unit(u, args, lds);
        if (!merge_first) attn_merge_rows((const bf16*)args.out, (const float*)((unsigned char*)args.out + 48 * MiB), (bf16*)(ws + WS_O), vcu * NWAVES + (tid >> 6), G * NWAVES, tid & 63);
        SEAM(4);
    }
    if (IN(5)) {
        pg8::DenseOrder S; S.init(ws + WS_O, ws + WS_WOUT, M, D, D, G, bx);
        pg8::EpiResBf16 E{args.in[0], (bf16*)(ws + WS_N2)};
        pg8::gemm_phase<pg8::EpiResBf16, pg8::DenseOrder, false>(lds, D, S, E);
        SEAM(5);
    }
    if (IN(6)) { p5_router(args, lds, vcu, G); SEAM(6); }
    if (IN(7)) {
        moe_prefix(args, lds, G);
        pg8::MoeOrder S{(const LAS int*)(lds + LDS_PB), (const LAS int*)(lds + LDS_PBA), (const LAS int*)(lds + LDS_CNT), (const int*)(ws + WS_LIST), (const char*)(ws + WS_N2), (const char*)(ws + WS_W13), D, 4, G, vcu, 1, (size_t)D * D * 2};
        pg8::EpiMoeUp E{(bf16*)(ws + WS_HID), (const float*)(ws + WS_LRS), (const float*)(ws + WS_LGW), (const LAS int*)(lds + LDS_PBA)};
        pg8::gemm_phase<pg8::EpiMoeUp, pg8::MoeOrder, true>(lds, D, S, E);
        moe_tail_tasks<true>(args, lds, vcu, G);
        SEAM(7);
    }
    if (IN(8)) {
        if (!IN(7)) moe_prefix(args, lds, G);
        pg8::MoeOrder S{(const LAS int*)(lds + LDS_PB), (const LAS int*)(lds + LDS_PBA), (const LAS int*)(lds + LDS_CNT), (const int*)(ws + WS_LIST), (const char*)(ws + WS_HID), (const char*)(ws + WS_W2), FF, 4, G, vcu, 0, (size_t)D * FF * 2};
        pg8::EpiMoeDown E{(bf16*)(ws + WS_Y), (const int*)(ws + WS_LIST)};
        pg8::gemm_phase<pg8::EpiMoeDown, pg8::MoeOrder, true>(lds, FF, S, E);
        moe_tail_tasks<false>(args, lds, vcu, G);
        SEAM(8);
    }
    if (IN(9)) { p8_final(args, vcu, G, args.out); }
#undef IN
#undef SEAM
}
static void launch_fwd(const Args& base, int lo, int hi, int grid, hipStream_t stream) {
    Args a = base; a.ph_lo = lo; a.ph_hi = hi;
    hipLaunchKernelGGL(fwd, dim3(grid), dim3(NTHREADS), LDS_BYTES, stream, a);
}
extern "C" void kernel_launch(void* const* d_in, const int* in_sizes, int n_in, void* d_out, int out_size, void* d_ws, size_t ws_size, hipStream_t stream) {
    if (n_in != 16 || in_sizes[0] != M * D || out_size != M * D || ws_size < WS_END) { fprintf(stderr, "kernel_launch: unexpected shapes (n_in %d, ws %zu)\n", n_in, ws_size); return; }
    static int grid = 0;
    if (grid == 0) {
        int dev = 0, cus = 0;
        if (hipGetDevice(&dev) != hipSuccess || hipDeviceGetAttribute(&cus, hipDeviceAttributeMultiprocessorCount, dev) != hipSuccess) { grid = -1; return; }
        if (hipFuncSetAttribute((const void*)fwd, hipFuncAttributeMaxDynamicSharedMemorySize, LDS_BYTES) != hipSuccess) { fprintf(stderr, "kernel_launch: hipFuncSetAttribute failed\n"); grid = -1; return; }
        int per_cu = 0;
        if (hipOccupancyMaxActiveBlocksPerMultiprocessor(&per_cu, (const void*)fwd, NTHREADS, LDS_BYTES) != hipSuccess || per_cu < 1) fprintf(stderr, "kernel_launch: occupancy query says %d\n", per_cu);
        (void)hipGetLastError();
        grid = cus;
    }
    if (grid < 0) return;
    unsigned char* ws = (unsigned char*)d_ws; float* out = (float*)d_out;
    (void)hipMemsetAsync(ws + WS_CTL, 0, CTL_BYTES, stream);
    Args a{};
    for (int i = 0; i < 16; ++i) a.in[i] = (const float*)d_in[i];
    a.out = out; a.ws = ws;
    launch_fwd(a, 0, 10, grid, stream);
}
```

```cpp
#include <hip/hip_runtime.h>
#include <stdint.h>
#include <stdio.h>

typedef unsigned short bf16;
typedef short bf16x8 __attribute__((ext_vector_type(8)));
typedef float f32x4 __attribute__((ext_vector_type(4)));

__device__ __forceinline__ float bf2f(bf16 b) { return __uint_as_float(((unsigned)b) << 16); }
__device__ __forceinline__ bf16 f2bf(float f) { unsigned u = __float_as_uint(f); u += 0x7fffu + ((u >> 16) & 1u); return (bf16)(u >> 16); }

constexpr int BATCH = 2, T = 8192, M = BATCH * T, D = 1024;
constexpr int INC = 3088;
constexpr int NPROJ = 3072;
constexpr int C_GQ = 0, C_GK = 256, C_GV = 512, C_GR = 1024, C_AQ = 1536, C_AK = 2048, C_AV = 2560;
constexpr int GLR_SRC = 1536;
constexpr int NE = 32, FF = 512;
constexpr float EPS = 1e-6f;
constexpr int LIST_CAP = 16384;

constexpr size_t MiB = 1u << 20;
constexpr size_t WS_CTL = 0, CTL_BYTES = 1 * MiB;
constexpr size_t WS_WRT = 1 * MiB;
constexpr size_t WS_WOUT = 2 * MiB;
constexpr size_t WS_W13 = 4 * MiB;
constexpr size_t WS_W2 = 68 * MiB;
constexpr size_t WS_R = 100 * MiB;
constexpr size_t WS_WIN = WS_R;
constexpr size_t WS_GLR = WS_R + 6 * MiB;
constexpr size_t WS_GLAS = WS_R + 7 * MiB;
constexpr size_t WS_N1 = WS_R + 16 * MiB;
constexpr size_t WS_O = WS_N1;
constexpr size_t WS_PROJ = WS_R + 48 * MiB;
constexpr size_t WS_Y = WS_R;
constexpr size_t WS_N2 = WS_R + 64 * MiB;
constexpr size_t WS_HID = WS_R + 96 * MiB;
constexpr size_t WS_ROUTE = WS_R + 136 * MiB;
constexpr size_t WS_RSTD = WS_ROUTE + 512 * 1024;
constexpr size_t WS_LIST = WS_R + 137 * MiB;
constexpr size_t WS_LRS = WS_R + 139 * MiB;
constexpr size_t WS_LGW = WS_R + 141 * MiB;
constexpr size_t WS_END = WS_R + 144 * MiB;
constexpr int CW_CNT = 64;

struct Route { int e0, e1; float w0, w1; };

__device__ __forceinline__ float wave_sum(float v) {
#pragma unroll
    for (int o = 1; o < 64; o <<= 1) v += __shfl_xor(v, o);
    return v;
}
__device__ __forceinline__ float logsigmoid(float z) { return fminf(z, 0.f) - log1pf(__expf(-fabsf(z))); }
#define LAS __attribute__((address_space(3)))
#define GAS __attribute__((address_space(1)))
typedef unsigned u32x4 __attribute__((ext_vector_type(4)));
typedef unsigned u32x2 __attribute__((ext_vector_type(2)));
namespace pg8 {
constexpr int BM = 256, BK = 64, HALF = 128, HTB = HALF * BK * 2, STAGE_BYTES = 8 * HTB, NXCD = 8, WGM = 8;
__host__ __device__ __forceinline__ int lds_byte(int r, int c) { const int st = (r >> 4) * 2 + (c >> 5), rr = r & 15, cc = c & 31, ob = rr * 64 + cc * 2; return st * 1024 + (ob ^ (((ob >> 9) & 1) << 5)); }
__host__ __device__ __forceinline__ void stage_rc(int b, int& R, int& C) { const int st = b / 1024, sb = b % 1024, swz = sb ^ (((sb >> 9) & 1) << 5); R = (st >> 1) * 16 + swz / 64; C = (st & 1) * 32 + (swz % 64) / 2; }
__host__ __device__ __forceinline__ int perm32(int rho) { const int n = rho >> 4, i = rho & 15; return 8 * (i >> 2) + 4 * n + (i & 3); }
struct Unit { int pm, pn, e, nrows; };
typedef float f32x2_t __attribute__((ext_vector_type(2))); typedef __bf16 bf16x2_t __attribute__((ext_vector_type(2)));
__device__ __forceinline__ unsigned cvt_pk_bf16(float lo, float hi) { const f32x2_t v = {lo, hi}; const bf16x2_t b = __builtin_convertvector(v, bf16x2_t); return __builtin_bit_cast(unsigned, b); }

__device__ __forceinline__ void st16_wt(void* p, u32x4 v) { asm volatile("global_store_dwordx4 %0, %1, off sc1\n\ts_nop 1" :: "v"(p), "v"(v) : "memory"); }

struct DenseOrder {
    int nM, nN, nwg, G, c, K; const char* A; const char* Bt;
    __device__ void init(const void* A_, const void* Bt_, int M_, int N_, int K_, int G_, int c_) { A = (const char*)A_; Bt = (const char*)Bt_; nM = M_ / BM; nN = N_ / BM; nwg = nM * nN; G = G_; c = c_; K = K_; }
    __device__ __forceinline__ bool next(int i, Unit& u) const {
        const long L = (long)i * G + c; if (L >= nwg) return false;
        int wgid = (int)L; { const int q = nwg / NXCD, r = nwg % NXCD, xcd = wgid % NXCD, off = wgid / NXCD; wgid = (xcd < r ? xcd * (q + 1) : r * (q + 1) + (xcd - r) * q) + off; }
        const int nig = WGM * nN, gid = wgid / nig, fm = gid * WGM, gsz = (nM - fm) < WGM ? (nM - fm) : WGM;
        u.pm = fm + ((wgid % nig) % gsz); u.pn = (wgid % nig) / gsz; u.e = 0; u.nrows = 256; return true;
    }
    __device__ __forceinline__ void a_off(const Unit& u, const int (&R)[2], const int (&C)[2], unsigned (&off)[2][2]) const {
#pragma unroll
        for (int h = 0; h < 2; ++h)
#pragma unroll
            for (int i = 0; i < 2; ++i) off[h][i] = (unsigned)(((u.pm * BM + h * HALF + R[i]) * K + C[i]) * 2);
    }
    __device__ __forceinline__ const char* a_base() const { return A; }
    __device__ __forceinline__ const char* b_base(const Unit& u) const { return Bt + (size_t)u.pn * BM * K * 2; }
};

template <class Base> struct RangeOrder {
    Base base; int i0, i1;
    __device__ __forceinline__ bool next(int i, Unit& u) const { return (i + i0 < i1) && base.next(i + i0, u); }
    __device__ __forceinline__ void a_off(const Unit& u, const int (&R)[2], const int (&C)[2], unsigned (&off)[2][2]) const { base.a_off(u, R, C, off); }
    __device__ __forceinline__ const char* a_base() const { return base.a_base(); }
    __device__ __forceinline__ const char* b_base(const Unit& u) const { return base.b_base(u); }
};
struct EpiBf16 {
    static constexpr bool PERM = true;
    bf16* O; int ldc;
    __device__ __forceinline__ void operator()(const f32x4 (&acc)[2][2][4][2], const Unit& u, int wr, int wc, int fr, int fq) const {
        const int row0 = u.pm * BM + wr * 64 + fr, col0 = u.pn * BM + wc * 32 + 8 * fq;
#pragma unroll
        for (int ai = 0; ai < 2; ++ai)
#pragma unroll
            for (int m = 0; m < 4; ++m) { bf16* rowp = O + (size_t)(row0 + ai * HALF + m * 16) * ldc + col0;
#pragma unroll
                for (int bj = 0; bj < 2; ++bj) { const f32x4 v0 = acc[ai][bj][m][0], v1 = acc[ai][bj][m][1];
                    u32x4 w; w.x = cvt_pk_bf16(v0[0], v0[1]); w.y = cvt_pk_bf16(v0[2], v0[3]); w.z = cvt_pk_bf16(v1[0], v1[1]); w.w = cvt_pk_bf16(v1[2], v1[3]);
                    st16_wt(rowp + bj * HALF, w); } }
    }
};

struct EpiResBf16 {
    static constexpr bool PERM = true;
    const float* X; bf16* H;
    __device__ __forceinline__ void operator()(const f32x4 (&acc)[2][2][4][2], const Unit& u, int wr, int wc, int fr, int fq) const {
        const int row0 = u.pm * BM + wr * 64 + fr, col0 = u.pn * BM + wc * 32 + 8 * fq;
        f32x4 xv[2][8];
#define RES_LOAD(b, dst) { _Pragma("unroll") for (int mm = 0; mm < 2; ++mm) { const float* xp = X + (size_t)(row0 + ((b) >> 1) * HALF + (2 * ((b) & 1) + mm) * 16) * D + col0; \
            _Pragma("unroll") for (int bj = 0; bj < 2; ++bj) { dst[mm * 4 + bj * 2] = __builtin_nontemporal_load((const f32x4*)(xp + bj * HALF)); dst[mm * 4 + bj * 2 + 1] = __builtin_nontemporal_load((const f32x4*)(xp + bj * HALF + 4)); } } }
        RES_LOAD(0, xv[0]);
#pragma unroll
        for (int b = 0; b < 4; ++b) {
            if (b + 1 < 4) RES_LOAD(b + 1, xv[(b + 1) & 1]);
            const int ai = b >> 1;
#pragma unroll
            for (int mm = 0; mm < 2; ++mm) { const int m = 2 * (b & 1) + mm; bf16* rowp = H + (size_t)(row0 + ai * HALF + m * 16) * D + col0;
#pragma unroll
                for (int bj = 0; bj < 2; ++bj) { const f32x4 v0 = acc[ai][bj][m][0] + xv[b & 1][mm * 4 + bj * 2], v1 = acc[ai][bj][m][1] + xv[b & 1][mm * 4 + bj * 2 + 1];
                    u32x4 w; w.x = cvt_pk_bf16(v0[0], v0[1]); w.y = cvt_pk_bf16(v0[2], v0[3]); w.z = cvt_pk_bf16(v1[0], v1[1]); w.w = cvt_pk_bf16(v1[2], v1[3]);
                    st16_wt(rowp + bj * HALF, w); } }
        }
#undef RES_LOAD
    }
};

template <class Epi, class Sched, bool ALIGN_EPI>
__device__ __forceinline__ void gemm_phase(LAS unsigned char* lds, int K, const Sched& S, const Epi& E) {
    const int tid = threadIdx.x, wid = __builtin_amdgcn_readfirstlane(tid >> 6), lane = tid & 63, wr = wid >> 2, wc = wid & 3, fr = lane & 15, fq = lane >> 4;
    const int nt = K / BK;
    int Rr[2], Cc[2]; unsigned voffB[2];
#pragma unroll
    for (int i = 0; i < 2; ++i) { int R, C; stage_rc(tid * 16 + i * 8192, R, C); const int Rb = Epi::PERM ? ((R & ~31) + perm32(R & 31)) : R; Rr[i] = R; Cc[i] = C; voffB[i] = (unsigned)(Rb * K + C) * 2u; }
    const size_t kstep = (size_t)(BK * 2);
    const size_t hstep = (size_t)HALF * K * 2;
    const unsigned ldsw = (unsigned)wid * 1024u;
    const int aoff = lds_byte(wr * 64 + fr, fq * 8), boff = lds_byte(wc * 32 + fr, fq * 8);
    const char* const Ab = S.a_base();
#define PG8_SA(b, h) (((b) * 2 + (h)) * HTB)
#define PG8_SB(b, h) ((4 + (b) * 2 + (h)) * HTB)
#define PG8_STAGE_B(bufoff, gbase) do { _Pragma("unroll") for (int _i = 0; _i < 2; ++_i) \
        __builtin_amdgcn_global_load_lds((const unsigned*)((const char*)(gbase) + voffB[_i]), (LAS unsigned*)(lds + (bufoff) + ldsw + _i * 8192), 16, 0, 0); } while (0)
#define PG8_STAGE_A(bufoff, o0, o1, kb) do { \
        __builtin_amdgcn_global_load_lds((const unsigned*)(Ab + (o0) + (kb)), (LAS unsigned*)(lds + (bufoff) + ldsw), 16, 0, 0); \
        __builtin_amdgcn_global_load_lds((const unsigned*)(Ab + (o1) + (kb)), (LAS unsigned*)(lds + (bufoff) + ldsw + 8192), 16, 0, 0); } while (0)
#define PG8_LDA(dst, b, h) do { _Pragma("unroll") for (int m = 0; m < 4; ++m) _Pragma("unroll") for (int k = 0; k < 2; ++k) dst[m][k] = *(const LAS bf16x8*)(lds + PG8_SA(b, h) + aoff + m * 2048 + k * 1024); } while (0)
#define PG8_LDB(dst, b, h) do { _Pragma("unroll") for (int n = 0; n < 2; ++n) _Pragma("unroll") for (int k = 0; k < 2; ++k) dst[n][k] = *(const LAS bf16x8*)(lds + PG8_SB(b, h) + boff + n * 2048 + k * 1024); } while (0)
#define PG8_MMA(ai, bj, At, Bt) do { __builtin_amdgcn_s_setprio(1); _Pragma("unroll") for (int m = 0; m < 4; ++m) _Pragma("unroll") for (int n = 0; n < 2; ++n) _Pragma("unroll") for (int k = 0; k < 2; ++k) \
        acc[ai][bj][m][n] = __builtin_amdgcn_mfma_f32_16x16x32_bf16(Bt[n][k], At[m][k], acc[ai][bj][m][n], 0, 0, 0); __builtin_amdgcn_s_setprio(0); } while (0)
#define PG8_WAIT_V(n) asm volatile("s_waitcnt vmcnt(" #n ")" ::: "memory")
#define PG8_WAIT_L(n) asm volatile("s_waitcnt lgkmcnt(" #n ")" ::: "memory")
#define PG8_BAR __builtin_amdgcn_s_barrier()
#define PG8_SCHED __builtin_amdgcn_sched_barrier(0)
    Unit cur, nxt; int ui = 0;
    if (!S.next(0, cur)) return;
    f32x4 acc[2][2][4][2];
#pragma unroll
    for (int a = 0; a < 2; ++a)
#pragma unroll
        for (int b = 0; b < 2; ++b)
#pragma unroll
            for (int m = 0; m < 4; ++m)
#pragma unroll
                for (int n = 0; n < 2; ++n) acc[a][b][m][n] = (f32x4){0.f, 0.f, 0.f, 0.f};
    bf16x8 At[4][2], B0[2][2], B1[2][2];
    unsigned oc[2][2], on[2][2];
    S.a_off(cur, Rr, Cc, oc);
    const char* cB = S.b_base(cur);
    PG8_STAGE_B(PG8_SB(0, 0), cB); PG8_STAGE_B(PG8_SB(0, 1), cB + hstep); PG8_STAGE_A(PG8_SA(0, 0), oc[0][0], oc[0][1], 0); PG8_STAGE_A(PG8_SA(0, 1), oc[1][0], oc[1][1], 0);
    if (wr == 1) PG8_BAR;
    PG8_WAIT_V(2); PG8_BAR;
    PG8_STAGE_B(PG8_SB(1, 0), cB + kstep); PG8_STAGE_A(PG8_SA(1, 0), oc[0][0], oc[0][1], kstep); PG8_STAGE_B(PG8_SB(1, 1), cB + hstep + kstep);
    PG8_WAIT_V(6); PG8_BAR;
    for (;;) {
        const bool has_next = S.next(ui + 1, nxt);
        const char* nB = cB;
        if (has_next) { S.a_off(nxt, Rr, Cc, on); nB = S.b_base(nxt); }
        else {
#pragma unroll
            for (int h = 0; h < 2; ++h)
#pragma unroll
                for (int i = 0; i < 2; ++i) on[h][i] = oc[h][i]; }
        for (int t = 0; t < nt; t += 2) {
            const bool last = (t == nt - 2);
            const size_t k1 = (size_t)(t + 1) * kstep;
            const size_t k2 = last ? 0 : (size_t)(t + 2) * kstep, k3 = k2 + kstep;
            const char* b2 = last ? nB : cB + (size_t)(t + 2) * kstep; const char* b3 = b2 + kstep;
            const unsigned a20 = last ? on[0][0] : oc[0][0], a21 = last ? on[0][1] : oc[0][1], a30 = last ? on[1][0] : oc[1][0], a31 = last ? on[1][1] : oc[1][1];
            PG8_LDB(B0, 0, 0); PG8_LDB(B1, 0, 1); PG8_SCHED; PG8_LDA(At, 0, 0); PG8_STAGE_A(PG8_SA(1, 1), oc[1][0], oc[1][1], k1);
            PG8_WAIT_V(8); PG8_WAIT_L(0); PG8_BAR; PG8_MMA(0, 0, At, B0); PG8_MMA(0, 1, At, B1); PG8_BAR; PG8_SCHED;
            PG8_LDA(At, 0, 1); PG8_STAGE_B(PG8_SB(0, 0), b2); PG8_STAGE_B(PG8_SB(0, 1), b2 + hstep); PG8_STAGE_A(PG8_SA(0, 0), a20, a21, k2);
            PG8_WAIT_V(8); PG8_WAIT_L(0); PG8_BAR; PG8_MMA(1, 0, At, B0); PG8_MMA(1, 1, At, B1); PG8_BAR; PG8_SCHED;
            PG8_LDB(B0, 1, 0); PG8_LDB(B1, 1, 1); PG8_SCHED; PG8_LDA(At, 1, 0); PG8_STAGE_A(PG8_SA(0, 1), a30, a31, k2);
            PG8_WAIT_V(8); PG8_WAIT_L(0); PG8_BAR; PG8_MMA(0, 0, At, B0); PG8_MMA(0, 1, At, B1); PG8_BAR; PG8_SCHED;
            PG8_LDA(At, 1, 1); PG8_STAGE_B(PG8_SB(1, 0), b3); PG8_STAGE_B(PG8_SB(1, 1), b3 + hstep); PG8_STAGE_A(PG8_SA(1, 0), a20, a21, k3);
            PG8_WAIT_V(8); PG8_WAIT_L(0); PG8_BAR; PG8_MMA(1, 0, At, B0); PG8_MMA(1, 1, At, B1); PG8_BAR; PG8_SCHED;
        }
        if constexpr (ALIGN_EPI) { if (wr == 0) PG8_BAR; }
        E(acc, cur, wr, wc, fr, fq);
        if (!has_next) break;
#pragma unroll
        for (int a = 0; a < 2; ++a)
#pragma unroll
            for (int b = 0; b < 2; ++b)
#pragma unroll
                for (int m = 0; m < 4; ++m)
#pragma unroll
                    for (int n = 0; n < 2; ++n) acc[a][b][m][n] = (f32x4){0.f, 0.f, 0.f, 0.f};
        cur = nxt; cB = nB; ++ui;
#pragma unroll
        for (int h = 0; h < 2; ++h)
#pragma unroll
            for (int i = 0; i < 2; ++i) oc[h][i] = on[h][i];
        if constexpr (ALIGN_EPI) { if (wr == 1) PG8_BAR; }
    }
    PG8_WAIT_V(0);
    if constexpr (!ALIGN_EPI) { if (wr == 0) PG8_BAR; }
    PG8_BAR;
#undef PG8_SA
#undef PG8_SB
#undef PG8_STAGE_A
#undef PG8_STAGE_B
#undef PG8_LDA
#undef PG8_LDB
#undef PG8_MMA
#undef PG8_WAIT_V
#undef PG8_WAIT_L
#undef PG8_BAR
#undef PG8_SCHED
}
}
constexpr int NWAVES = 8, NTHREADS = NWAVES * 64;
constexpr int RING_BYTES = 131072;
constexpr int LDS_BYTES = 163840;
constexpr int LDSCTL_OFF = 162816;
constexpr int CW_BAR = 4096;
typedef GAS unsigned gu32;
#define RLX_AGENT __ATOMIC_RELAXED, __HIP_MEMORY_SCOPE_AGENT
#define LDS_WAIT() asm volatile("s_waitcnt lgkmcnt(0)" ::: "memory")
#define VM_WAIT() asm volatile("s_waitcnt vmcnt(0)" ::: "memory")
__device__ __forceinline__ unsigned pk2(float lo, float hi) { return pg8::cvt_pk_bf16(lo, hi); }

#define XB_TMO      128
#define XB_XCNT(j)  (256  + 64 * (j))
#define XB_XSUB(j)  (1280 + 64 * (j))
#define XB_XGEN(j)  (2304 + 64 * (j))
#define XB_TOP      3328
#define XB_TOPGEN   3392
#define XCD_BAR_WORDS 3456
#define XB_SPIN_CAP (1u << 18)
__device__ __forceinline__ unsigned xb_ld(unsigned* p)              { return __hip_atomic_load(p, __ATOMIC_RELAXED, __HIP_MEMORY_SCOPE_AGENT); }
__device__ __forceinline__ unsigned xb_add(unsigned* p, unsigned v) { return __hip_atomic_fetch_add(p, v, __ATOMIC_RELAXED, __HIP_MEMORY_SCOPE_AGENT); }
__device__ __forceinline__ unsigned xb_xcc_id() { return (unsigned)__builtin_amdgcn_s_getreg((3 << 11) | 20) & 0xFu; }
#define XB_SPIN(cond, bar) do { unsigned _sp = 0; while (cond) { __builtin_amdgcn_s_sleep(1); \
    if ((++_sp & 255u) == 0u) { if (xb_ld(&(bar)[XB_TMO])) break; if (_sp > XB_SPIN_CAP) { atomicAdd(&(bar)[XB_TMO], 1u); break; } } } } while (0)
struct XcdBarrier { unsigned* bar; unsigned x; volatile LAS unsigned* st; };
__device__ __forceinline__ XcdBarrier xcd_barrier_post(unsigned* bar, volatile LAS unsigned* st) {
    XcdBarrier b; b.bar = bar; b.x = xb_xcc_id(); b.st = st;
    if (threadIdx.x == 0) (void)xb_add(&bar[XB_XCNT(b.x)], 1u);
    return b;
}
__device__ __forceinline__ void xcd_barrier_complete(unsigned* bar, unsigned x, unsigned& nloc, unsigned& nx) {
    const unsigned G = gridDim.x * gridDim.y * gridDim.z;
    unsigned sum, cnt, mine, sp = 0u;
    for (;;) {
        sum = 0u; cnt = 0u; mine = 0u;
#pragma unroll
        for (unsigned j = 0; j < 16; ++j) { const unsigned c = xb_ld(&bar[XB_XCNT(j)]); sum += c; cnt += (c > 0u) ? 1u : 0u; mine = (j == x) ? c : mine; }
        if (sum == G) break;
        __builtin_amdgcn_s_sleep(1);
        if ((++sp & 255u) == 0u) { if (xb_ld(&bar[XB_TMO])) break; if (sp > XB_SPIN_CAP) { atomicAdd(&bar[XB_TMO], 1u); break; } }
    }
    nloc = mine > 0u ? mine : 1u; nx = cnt > 0u ? cnt : 1u;
}
__device__ __forceinline__ void xcd_barrier(const XcdBarrier& b) {
    asm volatile("s_waitcnt vmcnt(0)" ::: "memory");
    __syncthreads();
    if (threadIdx.x == 0) {
        unsigned* bar = b.bar;
        __builtin_amdgcn_s_waitcnt(0);
        unsigned nloc = b.st[0], nx = b.st[1];
        if (nloc == 0u) { xcd_barrier_complete(bar, b.x, nloc, nx); b.st[0] = nloc; b.st[1] = nx; }
        const unsigned old = xb_add(&bar[XB_XSUB(b.x)], 1u);
        const unsigned gen = old / nloc;
        if (old + 1u == (gen + 1u) * nloc) {
            __builtin_amdgcn_fence(__ATOMIC_RELEASE, "agent");
            asm volatile("s_waitcnt vmcnt(0)" ::: "memory");
            const unsigned og = xb_add(&bar[XB_TOP], 1u);
            const unsigned tg = og / nx;
            if (og + 1u == (tg + 1u) * nx) xb_add(&bar[XB_TOPGEN], 1u);
            else XB_SPIN(xb_ld(&bar[XB_TOPGEN]) == tg, bar);
            __builtin_amdgcn_fence(__ATOMIC_ACQUIRE, "agent");
            xb_add(&bar[XB_XGEN(b.x)], 1u);
            asm volatile("s_waitcnt vmcnt(0)" ::: "memory");
        } else {
            XB_SPIN(xb_ld(&bar[XB_XGEN(b.x)]) == gen, bar);
            __builtin_amdgcn_fence(__ATOMIC_ACQUIRE, "agent");
            asm volatile("s_waitcnt vmcnt(0)" ::: "memory");
        }
    }
    __syncthreads();
}

struct Args { const float* in[16]; float* out; unsigned char* ws; int ph_lo, ph_hi; };

template <bool SC>
__device__ __forceinline__ void tr_item(const float* src, int ld, bf16* dst, int K, LAS float* scr, int lane, const float* gk = nullptr) {
#pragma unroll 16
    for (int i = 0; i < 32; ++i) { const int kk = 2 * i + (lane >> 5); scr[kk * 33 + (lane & 31)] = __builtin_nontemporal_load(src + (size_t)kk * ld + (lane & 31)); }
    LDS_WAIT(); asm volatile("" ::: "memory");
    const int c = lane & 7;
    f32x4 g0 = {1.f, 1.f, 1.f, 1.f}, g1 = g0;
    if (SC) { g0 = *(const f32x4*)(gk + 8 * c); g1 = *(const f32x4*)(gk + 8 * c + 4); }
#pragma unroll
    for (int j = 0; j < 4; ++j) { const int n = (lane >> 3) + 8 * j; const LAS float* s = scr + (8 * c) * 33 + n;
        u32x4 o;
        if (SC) { o.x = pk2(s[0 * 33] * g0.x, s[1 * 33] * g0.y); o.y = pk2(s[2 * 33] * g0.z, s[3 * 33] * g0.w); o.z = pk2(s[4 * 33] * g1.x, s[5 * 33] * g1.y); o.w = pk2(s[6 * 33] * g1.z, s[7 * 33] * g1.w); }
        else { o.x = pk2(s[0 * 33], s[1 * 33]); o.y = pk2(s[2 * 33], s[3 * 33]); o.z = pk2(s[4 * 33], s[5 * 33]); o.w = pk2(s[6 * 33], s[7 * 33]); }
        __builtin_nontemporal_store(o, (GAS u32x4*)(dst + (size_t)n * K + 8 * c)); }
    LDS_WAIT(); asm volatile("" ::: "memory");
}
__device__ __forceinline__ float wave_reduce16(const float (&p)[16], int lane) {
    float a[8], b[4], c[2], d;
    { const bool hi = lane & 32;
#pragma unroll
      for (int i = 0; i < 8; ++i) { const float mine = hi ? p[i + 8] : p[i], theirs = hi ? p[i] : p[i + 8]; a[i] = mine + __shfl_xor(theirs, 32); } }
    { const bool hi = lane & 16;
#pragma unroll
      for (int i = 0; i < 4; ++i) { const float mine = hi ? a[i + 4] : a[i], theirs = hi ? a[i] : a[i + 4]; b[i] = mine + __shfl_xor(theirs, 16); } }
    { const bool hi = lane & 8;
#pragma unroll
      for (int i = 0; i < 2; ++i) { const float mine = hi ? b[i + 2] : b[i], theirs = hi ? b[i] : b[i + 2]; c[i] = mine + __shfl_xor(theirs, 8); } }
    { const bool hi = lane & 4; const float mine = hi ? c[1] : c[0], theirs = hi ? c[0] : c[1]; d = mine + __shfl_xor(theirs, 4); }
    d += __shfl_xor(d, 1); d += __shfl_xor(d, 2);
    return d;
}
__device__ __forceinline__ void p0_prologue(const Args& a, LAS unsigned char* lds, int vcu, int G) {
    const int tid = threadIdx.x, lane = tid & 63, wave = __builtin_amdgcn_readfirstlane(tid >> 6);
    unsigned char* ws = a.ws;
    const float* w_in = a.in[2]; const float* w_out = a.in[6]; const float* ew1 = a.in[12]; const float* ew3 = a.in[13]; const float* ew2 = a.in[14];
    bf16* WinT = (bf16*)(ws + WS_WIN); bf16* WoutT = (bf16*)(ws + WS_WOUT); bf16* W13T = (bf16*)(ws + WS_W13); bf16* W2T = (bf16*)(ws + WS_W2);
    const int gw = vcu * NWAVES + wave, NGW = G * NWAVES;
    {
        LAS float* wl = (LAS float*)(lds + 67584);
        for (int k = tid; k < D; k += NTHREADS) { const int slot = ((k & 3) + 4 * (k >> 8)) * 64 + ((k >> 2) & 63); const float* src = w_in + (size_t)k * INC + GLR_SRC;
#pragma unroll
            for (int q = 0; q < 4; ++q) *(LAS f32x4*)(wl + slot * 20 + 4 * q) = *(const f32x4*)(src + 4 * q); }
    }
    __syncthreads();
    {
        const float* x = a.in[0]; const float* g1 = a.in[1]; bf16* N1 = (bf16*)(ws + WS_N1); float* GLR = (float*)(ws + WS_GLR);
        const LAS float* wl = (const LAS float*)(lds + 67584);
        f32x4 g[4];
#pragma unroll
        for (int j = 0; j < 4; ++j) g[j] = ((const f32x4*)g1)[lane + 64 * j];
        f32x4 nv[4];
        if (gw < M) {
#pragma unroll
            for (int j = 0; j < 4; ++j) nv[j] = __builtin_nontemporal_load((const f32x4*)(x + (size_t)gw * D) + lane + 64 * j); }
#pragma unroll 1
        for (int m = gw; m < M; m += NGW) {
            f32x4 v[4]; float s = 0.f;
#pragma unroll
            for (int j = 0; j < 4; ++j) v[j] = nv[j];
            if (m + NGW < M) {
#pragma unroll
                for (int j = 0; j < 4; ++j) nv[j] = __builtin_nontemporal_load((const f32x4*)(x + (size_t)(m + NGW) * D) + lane + 64 * j); }
#pragma unroll
            for (int j = 0; j < 4; ++j) { s += (v[j].x * v[j].x + v[j].y * v[j].y) + (v[j].z * v[j].z + v[j].w * v[j].w); }
            const float rstd = rsqrtf(wave_sum(s) * (1.f / D) + EPS);
            GAS u32x2* o8 = (GAS u32x2*)(N1 + (size_t)m * D) + lane;
            float p[16];
#pragma unroll
            for (int r = 0; r < 16; ++r) p[r] = 0.f;
#pragma unroll
            for (int j = 0; j < 4; ++j) { v[j] = v[j] * rstd * g[j]; u32x2 w; w.x = pk2(v[j].x, v[j].y); w.y = pk2(v[j].z, v[j].w); o8[64 * j] = w;
#pragma unroll
                for (int jj = 0; jj < 4; ++jj) { const LAS float* wr = wl + ((jj + 4 * j) * 64 + lane) * 20; const float xv = v[j][jj];
#pragma unroll
                    for (int q = 0; q < 4; ++q) { const f32x4 wv = *(const LAS f32x4*)(wr + 4 * q); p[4 * q] += xv * wv.x; p[4 * q + 1] += xv * wv.y; p[4 * q + 2] += xv * wv.z; p[4 * q + 3] += xv * wv.w; }
                    if (jj & 1) asm volatile("" ::: "memory"); } }
            const float tot = wave_reduce16(p, lane);
            if ((lane & 3) == 0) GLR[(size_t)m * 16 + ((lane >> 2) & 15)] = tot;
        }
    }
    { const float* wg = a.in[8]; const float* we = a.in[10]; bf16* WRT = (bf16*)(ws + WS_WRT);
      for (int idx = gw * 64 + lane; idx < D * 36; idx += NGW * 64) { const int k = idx / 36, col = idx % 36; const float wv = (col < 4 ? wg[k * 4 + col] : we[k * 32 + col - 4]) * a.in[7][k];
          const bf16 hi = f2bf(wv), lo = f2bf(wv - bf2f(hi)); const int o = ((((k >> 5) * 2) * 36 + col) * 4 + ((k >> 3) & 3)) * 8 + (k & 7); WRT[o] = hi; WRT[o + 36 * 4 * 8] = lo; } }
    {
        LAS float* scr = (LAS float*)(lds + wave * 8448);
        constexpr int I_IN = 16 * 96, I_OUT = 16 * 32, NITEMS = I_IN + I_OUT;
        for (int it = gw; it < NITEMS; it += NGW) {
            int r = it;
            if (r < I_IN) { const int kb = r / 96, n0 = 32 * (r % 96); tr_item<false>(w_in + (size_t)(64 * kb) * INC + (n0 < 1536 ? n0 : n0 + 16), INC, WinT + (size_t)n0 * D + 64 * kb, D, scr, lane); continue; } r -= I_IN;
            { const int kb = r / 32, n0 = 32 * (r % 32); tr_item<false>(w_out + (size_t)(64 * kb) * D + n0, D, WoutT + (size_t)n0 * D + 64 * kb, D, scr, lane); }
        }
    }
}
struct TrDesc { const float* src; bf16* dst; const float* gk; int ld, K; };
__device__ __forceinline__ TrDesc expert_item(const Args& a, int r) {
    constexpr int I_13 = NE * 16 * 32; TrDesc d;
    if (r < I_13) { const int e = r / 512, q = r % 512, kb = q / 32, n0 = 32 * (q % 32); const float* w = ((n0 >> 7) & 1) ? a.in[13] : a.in[12];
        d.src = w + ((size_t)e * D + 64 * kb) * FF + 128 * (n0 >> 8) + (n0 & 127); d.ld = FF; d.dst = (bf16*)(a.ws + WS_W13) + (size_t)e * D * D + (size_t)n0 * D + 64 * kb; d.K = D; d.gk = a.in[7] + 64 * kb; }
    else { r -= I_13; const int e = r / 256, q = r % 256, kb = q / 32, n0 = 32 * (q % 32);
        d.src = a.in[14] + ((size_t)e * FF + 64 * kb) * D + n0; d.ld = D; d.dst = (bf16*)(a.ws + WS_W2) + (size_t)e * D * FF + (size_t)n0 * FF + 64 * kb; d.K = FF; d.gk = nullptr; }
    return d;
}
__device__ __forceinline__ void tr_fetch(const TrDesc& d, int lane, f32x4 (&r)[8], f32x4& g0, f32x4& g1) {
#pragma unroll
    for (int i = 0; i < 8; ++i) r[i] = __builtin_nontemporal_load((const f32x4*)(d.src + (size_t)(8 * i + (lane >> 3)) * d.ld + 4 * (lane & 7)));
    g0 = (f32x4){1.f, 1.f, 1.f, 1.f}; g1 = g0;
    if (d.gk) { g0 = *(const f32x4*)(d.gk + 8 * (lane & 7)); g1 = *(const f32x4*)(d.gk + 8 * (lane & 7) + 4); }
}
__device__ __forceinline__ void tr_finish(const TrDesc& d, int lane, const f32x4 (&r)[8], const f32x4 g0, const f32x4 g1, LAS float* scr) {
#pragma unroll
    for (int i = 0; i < 8; ++i) { LAS float* w = scr + (8 * i + (lane >> 3)) * 33 + 4 * (lane & 7); w[0] = r[i].x; w[1] = r[i].y; w[2] = r[i].z; w[3] = r[i].w; }
    LDS_WAIT(); asm volatile("" ::: "memory");
    const int c = lane & 7;
#pragma unroll
    for (int j = 0; j < 4; ++j) { const int n = (lane >> 3) + 8 * j; const LAS float* s = scr + (8 * c) * 33 + n;
        u32x4 o; o.x = pk2(s[0 * 33] * g0.x, s[1 * 33] * g0.y); o.y = pk2(s[2 * 33] * g0.z, s[3 * 33] * g0.w); o.z = pk2(s[4 * 33] * g1.x, s[5 * 33] * g1.y); o.w = pk2(s[6 * 33] * g1.z, s[7 * 33] * g1.w);
        __builtin_nontemporal_store(o, (GAS u32x4*)(d.dst + (size_t)n * d.K + 8 * c)); }
    LDS_WAIT(); asm volatile("" ::: "memory");
}
__device__ __forceinline__ void p0_expert_items(const Args& a, LAS unsigned char* lds, int first, int stride, int end) {
    const int lane = threadIdx.x & 63, wave = __builtin_amdgcn_readfirstlane(threadIdx.x >> 6);
    LAS float* scr = (LAS float*)(lds + wave * 8448);
    f32x4 r[4][8], g[4][2]; TrDesc d[4];
#pragma unroll
    for (int j = 0; j < 3; ++j) { const int it = first + j * stride; if (it < end) { d[j] = expert_item(a, it); tr_fetch(d[j], lane, r[j], g[j][0], g[j][1]); } }
#pragma unroll 1
    for (int it = first; it < end; it += 4 * stride) {
#pragma unroll
        for (int j = 0; j < 4; ++j) {
            const int cur = it + j * stride, nx = cur + 3 * stride;
            if (nx < end) { d[(j + 3) & 3] = expert_item(a, nx); tr_fetch(d[(j + 3) & 3], lane, r[(j + 3) & 3], g[(j + 3) & 3][0], g[(j + 3) & 3][1]); }
            if (cur < end) tr_finish(d[j], lane, r[j], g[j][0], g[j][1], scr);
        }
    }
}
__device__ __forceinline__ void p8_final(const Args& a, int vcu, int G, float* dst) {
    const int tid = threadIdx.x, lane = tid & 63, wave = __builtin_amdgcn_readfirstlane(tid >> 6);
    const int gw = vcu * NWAVES + wave, NGW = G * NWAVES;
    const bf16* Y = (const bf16*)(a.ws + WS_Y); float* out = a.out; const float* gf = a.in[15];
    f32x4 g[4];
#pragma unroll
    for (int j = 0; j < 4; ++j) g[j] = ((const f32x4*)gf)[lane + 64 * j];
#pragma unroll 1
    for (int m = gw; m < M; m += NGW) {
        const u32x2* hr = (const u32x2*)((const bf16*)(a.ws + WS_N2) + (size_t)m * D) + lane;
        const u32x2* y0 = (const u32x2*)(Y + (size_t)(2 * m) * D) + lane; const u32x2* y1 = y0 + D / 4;
        f32x4 v[4]; float s = 0.f;
#pragma unroll
        for (int j = 0; j < 4; ++j) { const u32x2 tv = __builtin_nontemporal_load(hr + 64 * j), p = __builtin_nontemporal_load(y0 + 64 * j), q = __builtin_nontemporal_load(y1 + 64 * j);
            v[j].x = __uint_as_float(tv.x << 16); v[j].y = __uint_as_float(tv.x & 0xffff0000u); v[j].z = __uint_as_float(tv.y << 16); v[j].w = __uint_as_float(tv.y & 0xffff0000u);
            v[j].x += __uint_as_float(p.x << 16) + __uint_as_float(q.x << 16); v[j].y += __uint_as_float(p.x & 0xffff0000u) + __uint_as_float(q.x & 0xffff0000u);
            v[j].z += __uint_as_float(p.y << 16) + __uint_as_float(q.y << 16); v[j].w += __uint_as_float(p.y & 0xffff0000u) + __uint_as_float(q.y & 0xffff0000u);
            s += (v[j].x * v[j].x + v[j].y * v[j].y) + (v[j].z * v[j].z + v[j].w * v[j].w); }
        const float rstd = rsqrtf(wave_sum(s) * (1.f / D) + EPS);
#pragma unroll
        for (int j = 0; j < 4; ++j) __builtin_nontemporal_store(v[j] * rstd * g[j], (f32x4*)(dst + (size_t)m * D) + lane + 64 * j);
    }
}

constexpr int LDS_PB = LDSCTL_OFF + 128;
constexpr int LDS_CNT = LDSCTL_OFF + 384;
constexpr int LDS_LCNT = 147456, LDS_LBASE = 147584, LDS_REC = 147712, REC_ITERS = 4;
constexpr int LDS_REX = 149760, REX_BYTES = 3200;
constexpr int CNT_STRIDE = 64;
__device__ __forceinline__ void p5_router(const Args& a, LAS unsigned char* lds, int vcu, int G) {
    const int tid = threadIdx.x, lane = tid & 63, wave = __builtin_amdgcn_readfirstlane(tid >> 6), fr = lane & 15, fq = lane >> 4, pr = wave >> 1, half = wave & 1;
    unsigned char* ws = a.ws;
    const float* bgp = a.in[9]; const float* be = a.in[11];
    const bf16* N2 = (const bf16*)(ws + WS_N2); float* RSTD = (float*)(ws + WS_RSTD); Route* ROUTE = (Route*)(ws + WS_ROUTE); int* LIST = (int*)(ws + WS_LIST);
    unsigned* cnt = (unsigned*)(ws + WS_CTL) + CW_CNT;
    { const u32x4* src = (const u32x4*)(ws + WS_WRT); LAS u32x4* dst = (LAS u32x4*)lds;
      for (int i = tid; i < 147456 / 16; i += NTHREADS) dst[i] = src[i]; }
    if (tid < NE) ((LAS unsigned*)(lds + LDS_LCNT))[tid] = 0u;
    __syncthreads();
    LAS unsigned* lcnt = (LAS unsigned*)(lds + LDS_LCNT); LAS unsigned* lbase = (LAS unsigned*)(lds + LDS_LBASE); LAS unsigned* rec = (LAS unsigned*)(lds + LDS_REC) + pr * (REC_ITERS * 32);
    LAS unsigned char* ex = lds + LDS_REX + pr * REX_BYTES; LAS float* lg = (LAS float*)ex;
    const int niter = (M / 16 + G * 4 - 1) / (G * 4);
#pragma unroll 1
    for (int it = 0; it < niter; ++it) {
        const int tile = vcu * 4 + pr + it * G * 4; const bool live = tile < M / 16;
        f32x4 acc[3]; acc[0] = (f32x4){0.f, 0.f, 0.f, 0.f}; acc[1] = acc[0]; acc[2] = acc[0]; float ssq = 0.f;
        if (live) {
            const int row = tile * 16 + fr;
            const bf16* hr = N2 + (size_t)row * D + 8 * fq + 512 * half;
            const LAS unsigned char* tb = lds + (fr * 4 + fq) * 16 + half * 16 * (2 * 36 * 64);
            const int o2 = ((32 + (fr & 3)) * 4 + fq) * 16 - (fr * 4 + fq) * 16;
            u32x4 ta[16];
#pragma unroll
            for (int s = 0; s < 16; ++s) ta[s] = __builtin_nontemporal_load((const u32x4*)(hr + 32 * s));
#pragma unroll
            for (int s = 0; s < 16; ++s) { const u32x4 tv = ta[s];
                const float hv[8] = {__uint_as_float(tv.x << 16), __uint_as_float(tv.x & 0xffff0000u), __uint_as_float(tv.y << 16), __uint_as_float(tv.y & 0xffff0000u),
                                     __uint_as_float(tv.z << 16), __uint_as_float(tv.z & 0xffff0000u), __uint_as_float(tv.w << 16), __uint_as_float(tv.w & 0xffff0000u)};
#pragma unroll
                for (int j = 0; j < 8; ++j) ssq += hv[j] * hv[j];
                const bf16x8 ah = __builtin_bit_cast(bf16x8, tv);
                const LAS unsigned char* th = tb + s * (2 * 36 * 64); const LAS unsigned char* tl = th + 36 * 64;
#pragma unroll
                for (int ct = 0; ct < 3; ++ct) { const int o = ct < 2 ? ct * 1024 : o2;
                    const bf16x8 bh = *(const LAS bf16x8*)(th + o), bl = *(const LAS bf16x8*)(tl + o);
                    acc[ct] = __builtin_amdgcn_mfma_f32_16x16x32_bf16(ah, bh, acc[ct], 0, 0, 0);
                    acc[ct] = __builtin_amdgcn_mfma_f32_16x16x32_bf16(ah, bl, acc[ct], 0, 0, 0); }
            }
            ssq += __shfl_xor(ssq, 16); ssq += __shfl_xor(ssq, 32);
            if (half) {
#pragma unroll
                for (int ct = 0; ct < 3; ++ct) *(LAS f32x4*)(ex + (ct * 64 + lane) * 16) = acc[ct];
                if (lane < 16) *(LAS float*)(ex + 3072 + lane * 4) = ssq; }
        }
        __syncthreads();
        if (live && !half) {
#pragma unroll
            for (int ct = 0; ct < 3; ++ct) acc[ct] += *(const LAS f32x4*)(ex + (ct * 64 + lane) * 16);
            ssq += *(const LAS float*)(ex + 3072 + fr * 4);
            const float rstd = rsqrtf(ssq * (1.f / D) + EPS);
            LDS_WAIT(); asm volatile("" ::: "memory");
#pragma unroll
            for (int ct = 0; ct < 3; ++ct)
#pragma unroll
                for (int r = 0; r < 4; ++r) { const int col = 16 * ct + fr; if (col < 36) lg[(4 * fq + r) * 36 + col] = acc[ct][r]; }
            LDS_WAIT(); asm volatile("" ::: "memory");
            if (lane < 16) {
                const LAS float* l = lg + 36 * lane; const int rw = tile * 16 + lane;
                int gi = 0; float gmax = l[0] * rstd + bgp[0];
                for (int c = 1; c < 4; ++c) { const float v = l[c] * rstd + bgp[c]; if (v > gmax) { gmax = v; gi = c; } }
                float den = 0.f; for (int c = 0; c < 4; ++c) den += __expf(l[c] * rstd + bgp[c] - gmax);
                const float gprob = 1.f / den;
                float b0 = -INFINITY, b1 = -INFINITY; int i0 = 0, i1 = 0;
                for (int c = 0; c < 8; ++c) { const float v = l[4 + gi * 8 + c] * rstd + be[gi * 8 + c]; if (v > b0) { b1 = b0; i1 = i0; b0 = v; i0 = c; } else if (v > b1) { b1 = v; i1 = c; } }
                const float e1x = __expf(b1 - b0); const float w0 = gprob / (1.f + e1x), w1 = gprob * e1x / (1.f + e1x);
                Route r; r.e0 = gi * 8 + i0; r.e1 = gi * 8 + i1; r.w0 = w0; r.w1 = w1; ROUTE[rw] = r; RSTD[rw] = rstd;
                const unsigned q0 = __hip_atomic_fetch_add(lcnt + r.e0, 1u, __ATOMIC_RELAXED, __HIP_MEMORY_SCOPE_WORKGROUP), q1 = __hip_atomic_fetch_add(lcnt + r.e1, 1u, __ATOMIC_RELAXED, __HIP_MEMORY_SCOPE_WORKGROUP);
                if (it < REC_ITERS) { rec[it * 32 + lane * 2] = ((unsigned)r.e0 << 16) | q0; rec[it * 32 + lane * 2 + 1] = ((unsigned)r.e1 << 16) | q1; }
            }
        }
        __syncthreads();
    }
    if (tid < NE) lbase[tid] = atomicAdd(&cnt[tid * CNT_STRIDE], lcnt[tid]);
    __syncthreads();
    if (!half && lane < 16) {
#pragma unroll 1
        for (int it = 0; it < niter && it < REC_ITERS; ++it) { const int tile = vcu * 4 + pr + it * G * 4; if (tile >= M / 16) break; const int rw = tile * 16 + lane;
            const Route rtw = ROUTE[rw]; const float rsw = RSTD[rw];
#pragma unroll
            for (int j = 0; j < 2; ++j) { const unsigned rc = rec[it * 32 + lane * 2 + j]; const int e = (int)(rc >> 16), idx = e * LIST_CAP + (int)(lbase[e] + (rc & 0xffffu));
                LIST[idx] = rw * 2 + j; ((float*)(ws + WS_LRS))[idx] = rsw; ((float*)(ws + WS_LGW))[idx] = j ? rtw.w1 : rtw.w0; } } }
}
namespace pg8 {
struct MoeOrder {
    const LAS int* pb; const LAS int* pba; const LAS int* cn; const int* list; const char* A; const char* W; int K, nN, G, c, gather; size_t wstride;
    __device__ __forceinline__ bool next(int i, Unit& u) const {
        const int L = i * G + c, NB = pb[NE]; if (L >= NB * nN) return false;
        const int rb = L / nN; u.pn = L % nN;
        int e = 0;
#pragma unroll
        for (int s = 16; s >= 1; s >>= 1) if (pb[e + s] <= rb) e += s;
        u.e = e; u.pm = rb - pb[e]; const int left = cn[e] - 256 * u.pm; u.nrows = left < 256 ? left : 256; return true;
    }
    __device__ __forceinline__ void a_off(const Unit& u, const int (&R)[2], const int (&C)[2], unsigned (&off)[2][2]) const {
#pragma unroll
        for (int h = 0; h < 2; ++h)
#pragma unroll
            for (int i = 0; i < 2; ++i) { const int r = h * HALF + R[i];
                if (gather) { const int tok = r < u.nrows ? (list[u.e * LIST_CAP + 256 * u.pm + r] >> 1) : 0; off[h][i] = (unsigned)((tok * K + C[i]) * 2); }
                else off[h][i] = (unsigned)(((256 * (pba[u.e] + u.pm) + r) * K + C[i]) * 2); }
    }
    __device__ __forceinline__ const char* a_base() const { return A; }
    __device__ __forceinline__ const char* b_base(const Unit& u) const { return W + (size_t)u.e * wstride + (size_t)u.pn * BM * K * 2; }
};
struct EpiMoeUp {
    static constexpr bool PERM = true;
    bf16* HID; const float* lrs; const float* lgw; const LAS int* pba;
    __device__ __forceinline__ void operator()(const f32x4 (&acc)[2][2][4][2], const Unit& u, int wr, int wc, int fr, int fq) const {
        const int prow0 = 256 * (pba[u.e] + u.pm);
#pragma unroll
        for (int ai = 0; ai < 2; ++ai)
#pragma unroll
            for (int m = 0; m < 4; ++m) { const int r = ai * HALF + wr * 64 + m * 16 + fr;
                const int li = u.e * LIST_CAP + 256 * u.pm + (r < u.nrows ? r : 0); const float rs = lrs[li], gw = lgw[li];
                float hv[8];
#pragma unroll
                for (int n = 0; n < 2; ++n)
#pragma unroll
                    for (int q = 0; q < 4; ++q) { const float x = acc[ai][0][m][n][q] * rs, y = acc[ai][1][m][n][q] * rs; hv[4 * n + q] = x * __builtin_amdgcn_rcpf(1.f + __expf(-x)) * (y * gw); }
                u32x4 w; w.x = cvt_pk_bf16(hv[0], hv[1]); w.y = cvt_pk_bf16(hv[2], hv[3]); w.z = cvt_pk_bf16(hv[4], hv[5]); w.w = cvt_pk_bf16(hv[6], hv[7]);
                *(u32x4*)(HID + (size_t)(prow0 + r) * FF + 128 * u.pn + 32 * wc + 8 * fq) = w; }
    }
};
struct EpiMoeDown {
    static constexpr bool PERM = true;
    bf16* Y; const int* list;
    __device__ __forceinline__ void operator()(const f32x4 (&acc)[2][2][4][2], const Unit& u, int wr, int wc, int fr, int fq) const {
#pragma unroll
        for (int ai = 0; ai < 2; ++ai)
#pragma unroll
            for (int m = 0; m < 4; ++m) { const int r = ai * HALF + wr * 64 + m * 16 + fr;
                if (r < u.nrows) { const int slot = list[u.e * LIST_CAP + 256 * u.pm + r];
                    bf16* rowp = Y + (size_t)slot * D + u.pn * BM + wc * 32 + 8 * fq;
#pragma unroll
                    for (int bj = 0; bj < 2; ++bj) { const f32x4 v0 = acc[ai][bj][m][0], v1 = acc[ai][bj][m][1];
                        u32x4 o; o.x = cvt_pk_bf16(v0[0], v0[1]); o.y = cvt_pk_bf16(v0[2], v0[3]); o.z = cvt_pk_bf16(v1[0], v1[1]); o.w = cvt_pk_bf16(v1[2], v1[3]);
                        pg8::st16_wt(rowp + bj * HALF, o); } } }
    }
};
}
constexpr int LDS_PBA = LDSCTL_OFF + 512, LDS_PTR = LDSCTL_OFF + 656;
__device__ __forceinline__ void moe_prefix(const Args& a, LAS unsigned char* lds, int G) {
    const unsigned* cnt = (const unsigned*)(a.ws + WS_CTL) + CW_CNT;
    LAS int* pb = (LAS int*)(lds + LDS_PB); LAS int* cn = (LAS int*)(lds + LDS_CNT); LAS int* pba = (LAS int*)(lds + LDS_PBA); LAS int* ptr = (LAS int*)(lds + LDS_PTR);
    __syncthreads();
    if (threadIdx.x < 64) {
        const int lane = threadIdx.x, e = lane & 31; const int c = (int)cnt[e * CNT_STRIDE];
        const int nf = c >> 8, tail = c & 255;
        int nbf = nf;
#pragma unroll
        for (int o = 1; o < 32; o <<= 1) nbf += __shfl_xor(nbf, o);
        const int cap = ((4 * nbf + G - 1) / G) * G / 4, x = cap - nbf;
        int rank = 0;
#pragma unroll 1
        for (int j = 0; j < 32; ++j) { const int tj = __shfl(tail, j); rank += (tj > tail || (tj == tail && j < e)) ? 1 : 0; }
        const int istile = (tail > 0 && rank < x) ? 1 : 0;
        const int nbt = nf + istile, nba = (c + 255) >> 8, ntr = (!istile && tail > 0) ? ((tail + 31) >> 5) : 0;
        int s1 = nbt, s2 = nba, s3 = ntr;
#pragma unroll
        for (int o = 1; o < 32; o <<= 1) { const int t1 = __shfl_up(s1, o), t2 = __shfl_up(s2, o), t3 = __shfl_up(s3, o); if (e >= o) { s1 += t1; s2 += t2; s3 += t3; } }
        if (lane < 32) { cn[e] = c; pb[e + 1] = s1; pba[e + 1] = s2; ptr[e + 1] = s3; if (e == 0) { pb[0] = 0; pba[0] = 0; ptr[0] = 0; } }
    }
    __syncthreads();
}
template <int NJ> __device__ __forceinline__ void wave_mm_tail(const bf16* a0, const bf16* a1, const bf16* b0, size_t bstride16, int K, f32x4 (&acc)[2][NJ]) {
    const int fq = (threadIdx.x & 63) >> 4;
#pragma unroll 2
    for (int k0 = 0; k0 < K; k0 += 32) {
        const bf16x8 fa0 = *(const bf16x8*)(a0 + k0 + 8 * fq), fa1 = *(const bf16x8*)(a1 + k0 + 8 * fq);
#pragma unroll
        for (int j = 0; j < NJ; ++j) { const bf16x8 fb = *(const bf16x8*)(b0 + j * bstride16 + k0 + 8 * fq);
            acc[0][j] = __builtin_amdgcn_mfma_f32_16x16x32_bf16(fa0, fb, acc[0][j], 0, 0, 0); acc[1][j] = __builtin_amdgcn_mfma_f32_16x16x32_bf16(fa1, fb, acc[1][j], 0, 0, 0); }
    }
}
template <bool UP> __device__ __forceinline__ void moe_tail_tasks(const Args& a, LAS unsigned char* lds, int c_, int G) {
    const LAS int* pb = (const LAS int*)(lds + LDS_PB); const LAS int* cn = (const LAS int*)(lds + LDS_CNT); const LAS int* pba = (const LAS int*)(lds + LDS_PBA); const LAS int* ptr = (const LAS int*)(lds + LDS_PTR);
    const int tid = threadIdx.x, lane = tid & 63, wave = __builtin_amdgcn_readfirstlane(tid >> 6), fr = lane & 15;
    constexpr int NJ = UP ? 4 : 8, CW = 16 * NJ, NCT = (UP ? FF : D) / CW, K = UP ? D : FF, KW = K / NWAVES, NTILE = (UP ? 2 : 1) * 2 * NJ;
    const int NT = ptr[NE] * NCT;
    const int* list = (const int*)(a.ws + WS_LIST); const bf16* N2 = (const bf16*)(a.ws + WS_N2); bf16* HID = (bf16*)(a.ws + WS_HID);
    LAS f32x4* P = (LAS f32x4*)lds;
#pragma unroll 1
    for (int tt = c_; tt < NT; tt += G) {
        const int rt = tt / NCT, ct = tt % NCT;
        int e = 0;
#pragma unroll
        for (int s = 16; s >= 1; s >>= 1) if (ptr[e + s] <= rt) e += s;
        const int c = cn[e], r0 = 256 * (pb[e + 1] - pb[e]) + 32 * (rt - ptr[e]), prow = 256 * pba[e];
        const int p0 = r0 + fr, p1 = r0 + 16 + fr, k0 = wave * KW;
        if (UP) {
            const int t0 = p0 < c ? (list[e * LIST_CAP + p0] >> 1) : 0, t1 = p1 < c ? (list[e * LIST_CAP + p1] >> 1) : 0;
            const int j0 = ct * CW + fr, ra = 256 * (j0 >> 7) + (j0 & 127);
            const bf16* W = (const bf16*)(a.ws + WS_W13) + (size_t)e * D * D + k0;
            f32x4 accA[2][NJ] = {}, accB[2][NJ] = {};
            wave_mm_tail<NJ>(N2 + (size_t)t0 * D + k0, N2 + (size_t)t1 * D + k0, W + (size_t)ra * D, (size_t)16 * D, KW, accA);
            wave_mm_tail<NJ>(N2 + (size_t)t0 * D + k0, N2 + (size_t)t1 * D + k0, W + (size_t)(ra + 128) * D, (size_t)16 * D, KW, accB);
#pragma unroll
            for (int i = 0; i < 2; ++i)
#pragma unroll
                for (int j = 0; j < NJ; ++j) { P[(wave * NTILE + i * NJ + j) * 64 + lane] = accA[i][j]; P[(wave * NTILE + 2 * NJ + i * NJ + j) * 64 + lane] = accB[i][j]; }
        } else {
            const int q0 = p0 < c ? p0 : 0, q1 = p1 < c ? p1 : 0, c0 = ct * CW;
            const bf16* W = (const bf16*)(a.ws + WS_W2) + (size_t)e * D * FF + k0;
            f32x4 acc[2][NJ] = {};
            wave_mm_tail<NJ>(HID + (size_t)(prow + q0) * FF + k0, HID + (size_t)(prow + q1) * FF + k0, W + (size_t)(c0 + fr) * FF, (size_t)16 * FF, KW, acc);
#pragma unroll
            for (int i = 0; i < 2; ++i)
#pragma unroll
                for (int j = 0; j < NJ; ++j) P[(wave * NTILE + i * NJ + j) * 64 + lane] = acc[i][j];
        }
        __syncthreads();
        {
            const int ln = tid & 63, g = tid >> 6, frr = ln & 15, fqq = ln >> 4;
#pragma unroll
            for (int q = 0; q < (UP ? 1 : 2); ++q) { const int ij = UP ? g : 2 * g + q, i = ij / NJ, j = ij % NJ;
                f32x4 sa = (f32x4){0.f, 0.f, 0.f, 0.f}, sb = sa;
#pragma unroll
                for (int w = 0; w < NWAVES; ++w) { sa += P[(w * NTILE + ij) * 64 + ln]; if (UP) sb += P[(w * NTILE + 2 * NJ + ij) * 64 + ln]; }
#pragma unroll
                for (int r = 0; r < 4; ++r) { const int pos = r0 + 16 * i + 4 * fqq + r;
                    if (pos < c) {
                        const int slot = list[e * LIST_CAP + pos];
                        if (UP) { const float rs = ((const float*)(a.ws + WS_LRS))[e * LIST_CAP + pos], w = ((const float*)(a.ws + WS_LGW))[e * LIST_CAP + pos]; const float x = sa[r] * rs, y = sb[r] * rs;
                            HID[(size_t)(prow + pos) * FF + ct * CW + 16 * j + frr] = f2bf(x * __builtin_amdgcn_rcpf(1.f + __expf(-x)) * (y * w)); }
                        else ((bf16*)(a.ws + WS_Y))[(size_t)slot * D + ct * CW + 16 * j + frr] = f2bf(sa[r]); } } }
        }
        __syncthreads();
    }
}
typedef short v4i16_t __attribute__((ext_vector_type(4)));
typedef float f32x16 __attribute__((ext_vector_type(16)));
template <int RB> __device__ __forceinline__ int img_off(int row, int chunk) { return row * RB + ((chunk ^ (row & 7)) << 4); }
template <int RB> __device__ __forceinline__ bf16x8 frag_row(const LAS unsigned char* img, int row0, int k0, int lane) {
    return *(const LAS bf16x8*)(img + img_off<RB>(row0 + (lane & 31), (k0 >> 3) + (lane >> 5)));
}
template <int RB, bool PERMK> __device__ __forceinline__ bf16x8 frag_col(const LAS unsigned char* img, int k0, int n0, int lane) {
    const int h = lane >> 5, ch = (lane >> 4) & 1, q = (lane & 15) >> 2, p = lane & 3;
    const int ra = k0 + (PERMK ? 4 * h : 8 * h) + q, rb = ra + (PERMK ? 8 : 4);
    const int chunk = (n0 >> 3) + 2 * ch + (p >> 1), sub = (p & 1) * 8;
    const v4i16_t lo = __builtin_amdgcn_ds_read_tr16_b64_v4i16((LAS v4i16_t*)(img + img_off<RB>(ra, chunk) + sub));
    const v4i16_t hi = __builtin_amdgcn_ds_read_tr16_b64_v4i16((LAS v4i16_t*)(img + img_off<RB>(rb, chunk) + sub));
    return (bf16x8){lo[0], lo[1], lo[2], lo[3], hi[0], hi[1], hi[2], hi[3]};
}
__device__ __forceinline__ int crow(int r, int h) { return (r & 3) + 8 * (r >> 2) + 4 * h; }
__device__ __forceinline__ bf16x8 pack8(const f32x16& x, int s) {
    u32x4 w; w.x = pg8::cvt_pk_bf16(x[8 * s], x[8 * s + 1]); w.y = pg8::cvt_pk_bf16(x[8 * s + 2], x[8 * s + 3]); w.z = pg8::cvt_pk_bf16(x[8 * s + 4], x[8 * s + 5]); w.w = pg8::cvt_pk_bf16(x[8 * s + 6], x[8 * s + 7]);
    return __builtin_bit_cast(bf16x8, w);
}

constexpr int ATT_UNITS = BATCH * 8 * 3 * 32;
constexpr int ATT_LK = 0, ATT_LV = 49152, ATT_STG = 98304, ATT_WS = 131072;
constexpr float ATT_C = 0.125f * 1.4426950408889634f;
struct AttU { int b, head, br, d, r, i0; };
__device__ __forceinline__ AttU attn_decode(int u) { AttU a; const int x = u & 31; a.br = (u >> 5) % 3; const int bh = (u >> 5) / 3; a.b = bh >> 3; a.head = bh & 7;
    a.d = a.br == 0 ? 1 : (a.br == 1 ? 4 : 16); const int nblk = 32 / a.d; a.r = x / nblk; a.i0 = (x % nblk) * 256; return a; }
template <int WHICH> __device__ __forceinline__ void attn_fetch(const AttU& a, const bf16* proj, u32x4 (&kv)[6]) {
    const int tid = threadIdx.x; const bf16* pb = proj + (size_t)a.b * T * NPROJ + a.head * 64 + (WHICH ? C_AV : C_AK);
#pragma unroll
    for (int it = 0; it < 6; ++it) { const int c = tid + NTHREADS * it, row = c >> 3, ch = c & 7, ki = a.i0 - 128 + row, kc = ki < 0 ? 0 : ki;
        kv[it] = *(const u32x4*)(pb + (size_t)(kc * a.d + a.r) * NPROJ + ch * 8); }
}
template <int WHICH> __device__ __forceinline__ void attn_put(const u32x4 (&kv)[6], LAS unsigned char* lds) {
    const int tid = threadIdx.x;
#pragma unroll
    for (int it = 0; it < 6; ++it) { const int c = tid + NTHREADS * it, row = c >> 3, ch = c & 7; *(LAS u32x4*)(lds + (WHICH ? ATT_LV : ATT_LK) + img_off<128>(row, ch)) = kv[it]; }
}
__device__ __forceinline__ void attn_unit(const AttU& a, const AttU& an, u32x4 (&kk)[6], u32x4 (&vv)[6], const bf16* proj, bf16* OBR, float* ML, LAS unsigned char* lds) {
    const int tid = threadIdx.x, lane = tid & 63, w = __builtin_amdgcn_readfirstlane(tid >> 6), r32 = lane & 31, h = lane >> 5;
    const int d = a.d, r = a.r, i0 = a.i0, b = a.b, head = a.head, br = a.br;
    const bf16* pb = proj + (size_t)b * T * NPROJ + head * 64;
    bf16x8 qf[4];
    { const bf16* qp = pb + (size_t)((i0 + 32 * w + r32) * d + r) * NPROJ + C_AQ + 8 * h;
#pragma unroll
      for (int s = 0; s < 4; ++s) qf[s] = *(const bf16x8*)(qp + 16 * s); }
    attn_put<0>(kk, lds); attn_put<1>(vv, lds);
    __syncthreads();
    attn_fetch<0>(an, proj, kk);
    f32x16 S[5];
    { bf16x8 kf[2][4];
#pragma unroll
      for (int s = 0; s < 4; ++s) kf[0][s] = frag_row<128>(lds + ATT_LK, 32 * w, 16 * s, lane);
#pragma unroll
      for (int t = 0; t < 5; ++t) {
          if (t < 4) {
#pragma unroll
              for (int s = 0; s < 4; ++s) kf[(t + 1) & 1][s] = frag_row<128>(lds + ATT_LK, 32 * w + 32 * (t + 1), 16 * s, lane); }
          __builtin_amdgcn_sched_barrier(0);
          S[t] = (f32x16){};
#pragma unroll
          for (int s = 0; s < 4; ++s) S[t] = __builtin_amdgcn_mfma_f32_32x32x16_bf16(kf[t & 1][s], qf[s], S[t], 0, 0, 0);
          __builtin_amdgcn_sched_barrier(0); } }
    const int kbase = i0 + 32 * w - 128;
#pragma unroll
    for (int rr = 0; rr < 16; ++rr) { const int kr = crow(rr, h); S[0][rr] = (kr >= r32) ? S[0][rr] : -INFINITY; S[4][rr] = (kr <= r32) ? S[4][rr] : -INFINITY; }
    if (kbase < 0) {
#pragma unroll
        for (int t = 0; t < 5; ++t)
#pragma unroll
            for (int rr = 0; rr < 16; ++rr) S[t][rr] = (kbase + 32 * t + crow(rr, h)) >= 0 ? S[t][rr] : -INFINITY; }
    float mx = -INFINITY;
#pragma unroll
    for (int t = 0; t < 5; ++t)
#pragma unroll
        for (int rr = 0; rr < 16; ++rr) mx = fmaxf(mx, S[t][rr]);
    mx = fmaxf(mx, __shfl_xor(mx, 32)) * ATT_C;
    float ls = 0.f;
#pragma unroll
    for (int t = 0; t < 5; ++t)
#pragma unroll
        for (int rr = 0; rr < 16; ++rr) { const float pv = __builtin_amdgcn_exp2f(__builtin_fmaf(S[t][rr], ATT_C, -mx)); S[t][rr] = pv; ls += pv; }
    ls += __shfl_xor(ls, 32);
    bf16x8 pa[5][2];
#pragma unroll
    for (int t = 0; t < 5; ++t)
#pragma unroll
        for (int s2 = 0; s2 < 2; ++s2) pa[t][s2] = pack8(S[t], s2);
    __builtin_amdgcn_sched_barrier(0);
    attn_fetch<1>(an, proj, vv);
    __builtin_amdgcn_sched_barrier(0);
    f32x16 O[2]; O[0] = (f32x16){}; O[1] = (f32x16){};
    { bf16x8 vf[2][2];
#pragma unroll
      for (int db = 0; db < 2; ++db) vf[0][db] = frag_col<128, true>(lds + ATT_LV, 32 * w, 32 * db, lane);
#pragma unroll
      for (int i = 0; i < 10; ++i) { const int t = i >> 1, s2 = i & 1;
          if (i < 9) {
#pragma unroll
              for (int db = 0; db < 2; ++db) vf[(i + 1) & 1][db] = frag_col<128, true>(lds + ATT_LV, 32 * w + 16 * (i + 1), 32 * db, lane); }
          __builtin_amdgcn_sched_barrier(0);
#pragma unroll
          for (int db = 0; db < 2; ++db) O[db] = __builtin_amdgcn_mfma_f32_32x32x16_bf16(vf[i & 1][db], pa[t][s2], O[db], 0, 0, 0);
          __builtin_amdgcn_sched_barrier(0); } }
    { const float il = 1.f / ls;
      bf16* orow = OBR + ((size_t)br * M + (size_t)b * T + (size_t)((i0 + 32 * w + r32) * d + r)) * 512 + head * 64 + 8 * h;
#pragma unroll
      for (int db = 0; db < 2; ++db)
#pragma unroll
          for (int gp = 0; gp < 2; ++gp) {
              unsigned ax = pg8::cvt_pk_bf16(O[db][8 * gp] * il, O[db][8 * gp + 1] * il), ay = pg8::cvt_pk_bf16(O[db][8 * gp + 2] * il, O[db][8 * gp + 3] * il);
              unsigned bx2 = pg8::cvt_pk_bf16(O[db][8 * gp + 4] * il, O[db][8 * gp + 5] * il), by = pg8::cvt_pk_bf16(O[db][8 * gp + 6] * il, O[db][8 * gp + 7] * il);
              { const auto sx = __builtin_amdgcn_permlane32_swap(ax, bx2, false, false); ax = sx[0]; bx2 = sx[1]; }
              { const auto sy = __builtin_amdgcn_permlane32_swap(ay, by, false, false); ay = sy[0]; by = sy[1]; }
              *(u32x4*)(orow + 32 * db + 16 * gp) = (u32x4){ax, ay, bx2, by}; } }
    if (h == 0) { float* ml = ML + (((size_t)br * M + (size_t)b * T + (size_t)((i0 + 32 * w + r32) * d + r)) * 8 + head) * 2; ml[0] = mx; ml[1] = ls; }
    __syncthreads();
}
constexpr int ATT_SPLIT = ATT_UNITS / 2;
__device__ __forceinline__ void attn_units(int first, int stride, int end, const bf16* proj, bf16* OBR, float* ML, LAS unsigned char* lds) {
    if (first >= end) return;
    u32x4 kv[6], vv[6]; AttU cur = attn_decode(first); attn_fetch<0>(cur, proj, kv); attn_fetch<1>(cur, proj, vv);
#pragma unroll 1
    for (int u = first; u < end; u += stride) {
        const bool hn = u + stride < end; const AttU nxt = attn_decode(hn ? u + stride : u);
        attn_unit(cur, nxt, kv, vv, proj, OBR, ML, lds);
        cur = nxt;
    }
}
__device__ __forceinline__ void attn_merge_rows(const bf16* OBR, const float* ML, bf16* O, int gw, int NGW, int lane) {
    constexpr int MB = 4;
    const int head = lane >> 3;
#pragma unroll 1
    for (int m0 = gw; m0 < M; m0 += NGW * MB) {
        float mm[MB][3], ll[MB][3]; u32x4 ov[MB][3];
#pragma unroll
        for (int b = 0; b < MB; ++b) { const int m = min(m0 + b * NGW, M - 1);
#pragma unroll
            for (int br = 0; br < 3; ++br) { const float2 ml = *(const float2*)(ML + (((size_t)br * M + m) * 8 + head) * 2); mm[b][br] = ml.x; ll[b][br] = ml.y;
                ov[b][br] = __builtin_nontemporal_load((const u32x4*)(OBR + ((size_t)br * M + m) * 512 + lane * 8)); } }
#pragma unroll
        for (int b = 0; b < MB; ++b) { const int m = m0 + b * NGW;
            const float mxx = fmaxf(fmaxf(mm[b][0], mm[b][1]), mm[b][2]);
            float wgt[3], wsum = 0.f;
#pragma unroll
            for (int br = 0; br < 3; ++br) { wgt[br] = ll[b][br] * __builtin_amdgcn_exp2f(mm[b][br] - mxx); wsum += wgt[br]; }
            const float iw = 1.f / wsum; float acc[8];
#pragma unroll
            for (int e = 0; e < 8; ++e) acc[e] = 0.f;
#pragma unroll
            for (int br = 0; br < 3; ++br) { const float wb = wgt[br] * iw;
#pragma unroll
                for (int e = 0; e < 4; ++e) { const unsigned pk = ov[b][br][e]; acc[2 * e] += wb * __uint_as_float(pk << 16); acc[2 * e + 1] += wb * __uint_as_float(pk & 0xffff0000u); } }
            u32x4 o; o.x = pk2(acc[0], acc[1]); o.y = pk2(acc[2], acc[3]); o.z = pk2(acc[4], acc[5]); o.w = pk2(acc[6], acc[7]);
            if (m < M) *(u32x4*)(O + (size_t)m * D + 512 + lane * 8) = o;
        }
    }
}
constexpr int GLA_SEG = 256, GLA_NSEG = T / GLA_SEG, GLA_UNITS = BATCH * 4 * GLA_NSEG;
constexpr int GL_QP = 16384, GL_KP = 24576, GL_KPP = 32768, GL_V = 40960, GL_ST = 57344, GL_O = 73728, GL_PART = 107520, GL_GLR = 109568, GL_AL = 113664;
constexpr int GL_OLD = 132;
constexpr size_t WS_GLAS_A = WS_GLAS + 8 * MiB;
struct GLoad { f32x4 glr; u32x4 v[2]; bf16 k[8], q[8]; };
__device__ __forceinline__ float fast_logsigmoid(float z) {
    const float e = __builtin_amdgcn_exp2f(-fabsf(z) * 1.4426950408889634f);
    return fminf(z, 0.f) - __builtin_amdgcn_logf(1.f + e) * 0.6931471805599453f;
}
template <bool FULL> __device__ __forceinline__ void gla_fetch(GLoad& L, const bf16* proj, const float* glr, int b, int h, int t0) {
    const int tid = threadIdx.x, dk = tid & 63, tg = tid >> 6; const size_t row0 = (size_t)b * T + t0;
    L.glr = (f32x4){0.f, 0.f, 0.f, 0.f}; if (tid < 256) L.glr = ((const f32x4*)(glr + row0 * 16))[tid];
#pragma unroll
    for (int j = 0; j < 2; ++j) { const int c = tid + NTHREADS * j, tok = c >> 4, ch = c & 15; L.v[j] = *(const u32x4*)(proj + (row0 + tok) * NPROJ + C_GV + h * 128 + ch * 8); }
#pragma unroll
    for (int i = 0; i < 8; ++i) { const bf16* pr = proj + (row0 + tg * 8 + i) * NPROJ + h * 64 + dk; L.k[i] = pr[C_GK]; if (FULL) L.q[i] = pr[C_GQ]; }
}
template <bool FULL> __device__ __forceinline__ float gla_prep(const GLoad& L, const float (&w2r)[16], float bb, LAS unsigned char* lds) {
    const int tid = threadIdx.x, dk = tid & 63, tg = tid >> 6;
    LAS float* gl = (LAS float*)(lds + GL_GLR); LAS float* part = (LAS float*)(lds + GL_PART); LAS float* al = (LAS float*)(lds + GL_AL);
    if (tid < 256) *(LAS f32x4*)(gl + 4 * tid) = L.glr;
#pragma unroll
    for (int j = 0; j < 2; ++j) { const int c = tid + NTHREADS * j, tok = c >> 4, ch = c & 15; *(LAS u32x4*)(lds + GL_V + img_off<256>(tok, ch)) = L.v[j]; }
    __syncthreads();
    float la[8];
#pragma unroll
    for (int i = 0; i < 8; ++i) { const LAS float* g = gl + (tg * 8 + i) * 16; float z = bb;
#pragma unroll
        for (int q = 0; q < 4; ++q) { const f32x4 gv = *(const LAS f32x4*)(g + 4 * q); z += gv.x * w2r[4 * q] + gv.y * w2r[4 * q + 1] + gv.z * w2r[4 * q + 2] + gv.w * w2r[4 * q + 3]; }
        la[i] = fast_logsigmoid(z) * (1.f / 16.f); }
#pragma unroll
    for (int i = 1; i < 8; ++i) la[i] += la[i - 1];
    part[tg * 64 + dk] = la[7];
    __syncthreads();
    float offs = 0.f, glast = 0.f;
#pragma unroll
    for (int g = 0; g < 8; ++g) { const float pv = part[g * 64 + dk]; glast += pv; if (g < tg) offs += pv; }
    if (tg == 0) al[dk] = __expf(glast);
#pragma unroll
    for (int i = 0; i < 8; ++i) { const int tok = tg * 8 + i; const float G = offs + la[i];
        const float kv = bf2f(L.k[i]); const int o = img_off<128>(tok, dk >> 3) + (dk & 7) * 2;
        *(LAS bf16*)(lds + GL_KPP + o) = (bf16)pg8::cvt_pk_bf16(kv * __expf(glast - G), 0.f);
        if (FULL) { const float qv = bf2f(L.q[i]) * 0.125f; *(LAS bf16*)(lds + GL_QP + o) = (bf16)pg8::cvt_pk_bf16(qv * __expf(G), 0.f); *(LAS bf16*)(lds + GL_KP + o) = (bf16)pg8::cvt_pk_bf16(kv * __expf(-G), 0.f); } }
    return glast;
}
__device__ __forceinline__ void gla_state_update(f32x16& Sacc, LAS unsigned char* lds, int rb, int cb, int lane) {
    f32x16 U = (f32x16){};
#pragma unroll
    for (int s = 0; s < 4; ++s) U = __builtin_amdgcn_mfma_f32_32x32x16_bf16(frag_col<128, false>(lds + GL_KPP, 16 * s, 32 * rb, lane), frag_col<256, false>(lds + GL_V, 16 * s, 32 * cb, lane), U, 0, 0, 0);
    const LAS float* al = (const LAS float*)(lds + GL_AL);
#pragma unroll
    for (int r = 0; r < 16; ++r) Sacc[r] = al[32 * rb + crow(r, lane >> 5)] * Sacc[r] + U[r];
}
__device__ __forceinline__ void gla_pass1_unit(int u, const Args& a, LAS unsigned char* lds) {
    const int tid = threadIdx.x, lane = tid & 63, w = __builtin_amdgcn_readfirstlane(tid >> 6), rb = w >> 2, cb = w & 3;
    const int seg = u % GLA_NSEG, bh = u / GLA_NSEG, b = bh >> 2, h = bh & 3, dk = tid & 63;
    const bf16* proj = (const bf16*)(a.ws + WS_PROJ); const float* glr = (const float*)(a.ws + WS_GLR);
    float w2r[16];
#pragma unroll
    for (int r = 0; r < 16; ++r) w2r[r] = a.in[3][r * 256 + h * 64 + dk];
    const float bb = a.in[4][h * 64 + dk];
    f32x16 Sacc = (f32x16){}; float gsum = 0.f;
    GLoad L; gla_fetch<false>(L, proj, glr, b, h, seg * GLA_SEG);
#pragma unroll 1
    for (int c = 0; c < GLA_SEG / 64; ++c) {
        gsum += gla_prep<false>(L, w2r, bb, lds);
        if (c + 1 < GLA_SEG / 64) gla_fetch<false>(L, proj, glr, b, h, seg * GLA_SEG + (c + 1) * 64);
        __syncthreads();
        gla_state_update(Sacc, lds, rb, cb, lane);
        __syncthreads();
    }
    float* U = (float*)(a.ws + WS_GLAS) + (size_t)u * 64 * 128;
#pragma unroll
    for (int r = 0; r < 16; ++r) U[(32 * rb + crow(r, lane >> 5)) * 128 + 32 * cb + (lane & 31)] = Sacc[r];
    if (tid < 64) ((float*)(a.ws + WS_GLAS_A))[(size_t)u * 64 + dk] = __expf(gsum);
}
__device__ __forceinline__ void gla_pass2_unit(int u, const Args& a, LAS unsigned char* lds) {
    const int tid = threadIdx.x, lane = tid & 63, w = __builtin_amdgcn_readfirstlane(tid >> 6), rb = w >> 2, cb = w & 3, r32 = lane & 31, hh = lane >> 5;
    const int seg = u % GLA_NSEG, bh = u / GLA_NSEG, b = bh >> 2, h = bh & 3, dk = tid & 63;
    const bf16* proj = (const bf16*)(a.ws + WS_PROJ); const float* glr = (const float*)(a.ws + WS_GLR); bf16* Oo = (bf16*)(a.ws + WS_O);
    float w2r[16];
#pragma unroll
    for (int r = 0; r < 16; ++r) w2r[r] = a.in[3][r * 256 + h * 64 + dk];
    const float bb = a.in[4][h * 64 + dk];
    const int etok = tid >> 3, epart = tid & 7;
    float gn[16];
#pragma unroll
    for (int i = 0; i < 16; ++i) gn[i] = a.in[5][epart * 16 + i];
    f32x16 Sacc;
    { const float* Us = (const float*)(a.ws + WS_GLAS) + (size_t)u * 64 * 128;
#pragma unroll
      for (int r = 0; r < 16; ++r) Sacc[r] = Us[(32 * rb + crow(r, hh)) * 128 + 32 * cb + r32]; }
    GLoad L; gla_fetch<true>(L, proj, glr, b, h, seg * GLA_SEG);
#pragma unroll 1
    for (int c = 0; c < GLA_SEG / 64; ++c) {
        const int t0 = seg * GLA_SEG + c * 64;
#pragma unroll
        for (int g4 = 0; g4 < 4; ++g4) { u32x2 pk; pk.x = pg8::cvt_pk_bf16(Sacc[4 * g4], Sacc[4 * g4 + 1]); pk.y = pg8::cvt_pk_bf16(Sacc[4 * g4 + 2], Sacc[4 * g4 + 3]);
            *(LAS u32x2*)(lds + GL_ST + img_off<128>(32 * cb + r32, 4 * rb + g4) + 8 * hh) = pk; }
        (void)gla_prep<true>(L, w2r, bb, lds);
        if (c + 1 < GLA_SEG / 64) gla_fetch<true>(L, proj, glr, b, h, t0 + 64);
        const size_t erow = (size_t)b * T + t0 + etok;
        const u32x4* gp = (const u32x4*)(proj + erow * NPROJ + C_GR + h * 128 + epart * 16); const u32x4 g0 = gp[0], g1 = gp[1];
        __syncthreads();
        f32x16 Oa = (f32x16){};
#pragma unroll
        for (int t = 0; t < 2; ++t) if (t <= rb) {
            f32x16 X = (f32x16){};
#pragma unroll
            for (int s = 0; s < 4; ++s) X = __builtin_amdgcn_mfma_f32_32x32x16_bf16(frag_row<128>(lds + GL_KP, 32 * t, 16 * s, lane), frag_row<128>(lds + GL_QP, 32 * rb, 16 * s, lane), X, 0, 0, 0);
            if (t == rb) {
#pragma unroll
                for (int r = 0; r < 16; ++r) X[r] = crow(r, hh) <= r32 ? X[r] : 0.f; }
#pragma unroll
            for (int s2 = 0; s2 < 2; ++s2) Oa = __builtin_amdgcn_mfma_f32_32x32x16_bf16(pack8(X, s2), frag_col<256, true>(lds + GL_V, 32 * t + 16 * s2, 32 * cb, lane), Oa, 0, 0, 0);
        }
#pragma unroll
        for (int s = 0; s < 4; ++s) Oa = __builtin_amdgcn_mfma_f32_32x32x16_bf16(frag_row<128>(lds + GL_QP, 32 * rb, 16 * s, lane), frag_row<128>(lds + GL_ST, 32 * cb, 16 * s, lane), Oa, 0, 0, 0);
        gla_state_update(Sacc, lds, rb, cb, lane);
        { LAS float* ol = (LAS float*)(lds + GL_O);
#pragma unroll
          for (int r = 0; r < 16; ++r) ol[(32 * rb + crow(r, hh)) * GL_OLD + 32 * cb + r32] = Oa[r]; }
        __syncthreads();
        { const LAS float* ol = (const LAS float*)(lds + GL_O) + etok * GL_OLD + epart * 16; float ov[16]; float ss = 0.f;
#pragma unroll
          for (int q = 0; q < 4; ++q) { const f32x4 t4 = *(const LAS f32x4*)(ol + 4 * q); ov[4 * q] = t4.x; ov[4 * q + 1] = t4.y; ov[4 * q + 2] = t4.z; ov[4 * q + 3] = t4.w; ss += (t4.x * t4.x + t4.y * t4.y) + (t4.z * t4.z + t4.w * t4.w); }
          ss += __shfl_xor(ss, 1); ss += __shfl_xor(ss, 2); ss += __shfl_xor(ss, 4);
          const float rstd = rsqrtf(ss * (1.f / 128.f) + EPS);
          const size_t row = erow;
          const unsigned gw_[8] = {g0.x, g0.y, g0.z, g0.w, g1.x, g1.y, g1.z, g1.w}; float res[16];
#pragma unroll
          for (int i = 0; i < 8; ++i) { const float ga = __uint_as_float(gw_[i] << 16), gb = __uint_as_float(gw_[i] & 0xffff0000u);
              res[2 * i] = ov[2 * i] * rstd * gn[2 * i] * (ga * __builtin_amdgcn_rcpf(1.f + __expf(-ga))); res[2 * i + 1] = ov[2 * i + 1] * rstd * gn[2 * i + 1] * (gb * __builtin_amdgcn_rcpf(1.f + __expf(-gb))); }
          u32x4 o0, o1; o0.x = pk2(res[0], res[1]); o0.y = pk2(res[2], res[3]); o0.z = pk2(res[4], res[5]); o0.w = pk2(res[6], res[7]);
          o1.x = pk2(res[8], res[9]); o1.y = pk2(res[10], res[11]); o1.z = pk2(res[12], res[13]); o1.w = pk2(res[14], res[15]);
          u32x4* op = (u32x4*)(Oo + row * D + h * 128 + epart * 16); op[0] = o0; op[1] = o1; }
    }
    __syncthreads();
}
__device__ __forceinline__ void gla_scan(const Args& a, int blk) {
    if (blk >= BATCH * 4 * 16) return;
    const int bh = blk >> 4, elem = (blk & 15) * NTHREADS + threadIdx.x, dk = elem >> 7;
    float* U = (float*)(a.ws + WS_GLAS) + (size_t)bh * GLA_NSEG * 8192 + elem; const float* A = (const float*)(a.ws + WS_GLAS_A) + (size_t)bh * GLA_NSEG * 64 + dk;
    float uv[GLA_NSEG], av[GLA_NSEG];
#pragma unroll
    for (int j = 0; j < GLA_NSEG; ++j) { uv[j] = U[(size_t)j * 8192]; av[j] = A[j * 64]; }
    float S = 0.f;
#pragma unroll
    for (int j = 0; j < GLA_NSEG; ++j) { U[(size_t)j * 8192] = S; S = av[j] * S + uv[j]; }
}
__global__ void __launch_bounds__(NTHREADS, 2) fwd(Args args) {
    extern __shared__ __attribute__((aligned(16))) unsigned char lds_raw[];
    LAS unsigned char* lds = (LAS unsigned char*)lds_raw;
    const int tid = threadIdx.x;
    const int G = gridDim.x; const int bx = blockIdx.x; const int vcu = (G % 8 == 0) ? (bx % 8) * (G / 8) + bx / 8 : bx;
    unsigned char* ws = args.ws;
    unsigned* ctl = (unsigned*)(ws + WS_CTL);
    for (int u = tid; u < (LDS_BYTES - LDSCTL_OFF) / 4; u += NTHREADS) ((LAS unsigned*)(lds + LDSCTL_OFF))[u] = 0u;
    __syncthreads();
    const int lo = args.ph_lo, hi = args.ph_hi;
    XcdBarrier bar; bar.bar = ctl + CW_BAR; bar.x = 0; bar.st = nullptr;
    if (hi - lo > 1) bar = xcd_barrier_post(ctl + CW_BAR, (volatile LAS unsigned*)(lds + LDSCTL_OFF + 64));
#define IN(k) (lo <= (k) && (k) < hi)
#define SEAM(k) do { if (IN(k) && IN((k) + 1)) xcd_barrier(bar); } while (0)
    bf16* OBR = (bf16*)args.out; float* MLp = (float*)((unsigned char*)args.out + 48 * MiB);
    if (IN(0)) { p0_prologue(args, lds, vcu, G); SEAM(0); }
    if (IN(1)) {
        constexpr int NEI = NE * 16 * 32 + NE * 8 * 32;
        const bool four = (G >= 32) && (G % 32 == 0);
        const int ngrp = four ? 4 : 1, grp = four ? ((bx >> 3) & 3) : 0, rank = four ? ((bx >> 5) * 8 + (bx & 7)) : bx, per = G / ngrp;
        const int wv = __builtin_amdgcn_readfirstlane(tid >> 6);
        const int e_lo = grp * (NEI / ngrp), e_hi = (grp + 1) * (NEI / ngrp);
        const int nu = ((M / 256) * (NPROJ / 256) + G - 1) / G, cut = four ? (nu * grp) / 3 : 0;
        pg8::DenseOrder S; S.init(ws + WS_N1, ws + WS_WIN, M, NPROJ, D, G, bx);
        pg8::EpiBf16 E{(bf16*)(ws + WS_PROJ), NPROJ};
        if (cut > 0) { pg8::RangeOrder<pg8::DenseOrder> R0{S, 0, cut}; pg8::gemm_phase<pg8::EpiBf16, pg8::RangeOrder<pg8::DenseOrder>, true>(lds, D, R0, E); __syncthreads(); }
        p0_expert_items(args, lds, e_lo + rank * NWAVES + wv, per * NWAVES, e_hi);
        __syncthreads();
        if (cut < nu) { pg8::RangeOrder<pg8::DenseOrder> R1{S, cut, nu}; pg8::gemm_phase<pg8::EpiBf16, pg8::RangeOrder<pg8::DenseOrder>, true>(lds, D, R1, E); }
        SEAM(1);
    }
    if (IN(2)) {
        for (int i = bx; i < GLA_UNITS; i += G) gla_pass1_unit(i, args, lds);
        SEAM(2);
    }
    if (IN(3)) {
        for (int blk = bx; blk < BATCH * 4 * 16; blk += G) gla_scan(args, blk);
        attn_units(bx, G, ATT_UNITS, (const bf16*)(ws + WS_PROJ), OBR, MLp, lds);
        SEAM(3);
    }
    if (IN(4)) {
        const bool merge_first = (bx >> 3) & 1;
        if (merge_first) attn_merge_rows((const bf16*)args.out, (const float*)((unsigned char*)args.out + 48 * MiB), (bf16*)(ws + WS_O), vcu * NWAVES + (tid >> 6), G * NWAVES, tid & 63);
        for (int u = bx; u < GLA_UNITS; u += G) gla_pass2_unit(u, args, lds);
        if (!merge_first) attn_merge_rows((const bf16*)args.out, (const float*)((unsigned char*)args.out + 48 * MiB), (bf16*)(ws + WS_O), vcu * NWAVES + (tid >> 6), G * NWAVES, tid & 63);
        SEAM(4);
    }
    if (IN(5)) {
        pg8::DenseOrder S; S.init(ws + WS_O, ws + WS_WOUT, M, D, D, G, bx);
        pg8::EpiResBf16 E{args.in[0], (bf16*)(ws + WS_N2)};
        pg8::gemm_phase<pg8::EpiResBf16, pg8::DenseOrder, false>(lds, D, S, E);
        SEAM(5);
    }
    if (IN(6)) { p5_router(args, lds, vcu, G); SEAM(6); }
    if (IN(7)) {
        moe_prefix(args, lds, G);
        pg8::MoeOrder S{(const LAS int*)(lds + LDS_PB), (const LAS int*)(lds + LDS_PBA), (const LAS int*)(lds + LDS_CNT), (const int*)(ws + WS_LIST), (const char*)(ws + WS_N2), (const char*)(ws + WS_W13), D, 4, G, vcu, 1, (size_t)D * D * 2};
        pg8::EpiMoeUp E{(bf16*)(ws + WS_HID), (const float*)(ws + WS_LRS), (const float*)(ws + WS_LGW), (const LAS int*)(lds + LDS_PBA)};
        pg8::gemm_phase<pg8::EpiMoeUp, pg8::MoeOrder, true>(lds, D, S, E);
        moe_tail_tasks<true>(args, lds, vcu, G);
        SEAM(7);
    }
    if (IN(8)) {
        if (!IN(7)) moe_prefix(args, lds, G);
        pg8::MoeOrder S{(const LAS int*)(lds + LDS_PB), (const LAS int*)(lds + LDS_PBA), (const LAS int*)(lds + LDS_CNT), (const int*)(ws + WS_LIST), (const char*)(ws + WS_HID), (const char*)(ws + WS_W2), FF, 4, G, vcu, 0, (size_t)D * FF * 2};
        pg8::EpiMoeDown E{(bf16*)(ws + WS_Y), (const int*)(ws + WS_LIST)};
        pg8::gemm_phase<pg8::EpiMoeDown, pg8::MoeOrder, true>(lds, FF, S, E);
        moe_tail_tasks<false>(args, lds, vcu, G);
        SEAM(8);
    }
    if (IN(9)) { p8_final(args, vcu, G, args.out); }
#undef IN
#undef SEAM
}
static void launch_fwd(const Args& base, int lo, int hi, int grid, hipStream_t stream) {
    Args a = base; a.ph_lo = lo; a.ph_hi = hi;
    hipLaunchKernelGGL(fwd, dim3(grid), dim3(NTHREADS), LDS_BYTES, stream, a);
}
extern "C" void kernel_launch(void* const* d_in, const int* in_sizes, int n_in, void* d_out, int out_size, void* d_ws, size_t ws_size, hipStream_t stream) {
    if (n_in != 16 || in_sizes[0] != M * D || out_size != M * D || ws_size < WS_END) { fprintf(stderr, "kernel_launch: unexpected shapes (n_in %d, ws %zu)\n", n_in, ws_size); return; }
    static int grid = 0;
    if (grid == 0) {
        int dev = 0, cus = 0;
        if (hipGetDevice(&dev) != hipSuccess || hipDeviceGetAttribute(&cus, hipDeviceAttributeMultiprocessorCount, dev) != hipSuccess) { grid = -1; return; }
        if (hipFuncSetAttribute((const void*)fwd, hipFuncAttributeMaxDynamicSharedMemorySize, LDS_BYTES) != hipSuccess) { fprintf(stderr, "kernel_launch: hipFuncSetAttribute failed\n"); grid = -1; return; }
        int per_cu = 0;
        if (hipOccupancyMaxActiveBlocksPerMultiprocessor(&per_cu, (const void*)fwd, NTHREADS, LDS_BYTES) != hipSuccess || per_cu < 1) fprintf(stderr, "kernel_launch: occupancy query says %d\n", per_cu);
        (void)hipGetLastError();
        grid = cus;
    }
    if (grid < 0) return;
    unsigned char* ws = (unsigned char*)d_ws; float* out = (float*)d_out;
    (void)hipMemsetAsync(ws + WS_CTL, 0, CTL_BYTES, stream);
    Args a{};
    for (int i = 0; i < 16; ++i) a.in[i] = (const float*)d_in[i];
    a.out = out; a.ws = ws;
    launch_fwd(a, 0, 10, grid, stream);
}
```

```cpp
#include <hip/hip_runtime.h>
#include <stdint.h>
#include <stdio.h>

typedef unsigned short bf16;
typedef short bf16x8 __attribute__((ext_vector_type(8)));
typedef float f32x4 __attribute__((ext_vector_type(4)));

__device__ __forceinline__ float bf2f(bf16 b) { return __uint_as_float(((unsigned)b) << 16); }
__device__ __forceinline__ bf16 f2bf(float f) { unsigned u = __float_as_uint(f); u += 0x7fffu + ((u >> 16) & 1u); return (bf16)(u >> 16); }

constexpr int BATCH = 2, T = 8192, M = BATCH * T, D = 1024;
constexpr int INC = 3088;
constexpr int NPROJ = 3072;
constexpr int C_GQ = 0, C_GK = 256, C_GV = 512, C_GR = 1024, C_AQ = 1536, C_AK = 2048, C_AV = 2560;
constexpr int GLR_SRC = 1536;
constexpr int NE = 32, FF = 512;
constexpr float EPS = 1e-6f;
constexpr int LIST_CAP = 16384;

constexpr size_t MiB = 1u << 20;
constexpr size_t WS_CTL = 0, CTL_BYTES = 1 * MiB;
constexpr size_t WS_WRT = 1 * MiB;
constexpr size_t WS_WOUT = 2 * MiB;
constexpr size_t WS_W13 = 4 * MiB;
constexpr size_t WS_W2 = 68 * MiB;
constexpr size_t WS_R = 100 * MiB;
constexpr size_t WS_WIN = WS_R;
constexpr size_t WS_GLR = WS_R + 6 * MiB;
constexpr size_t WS_GLAS = WS_R + 7 * MiB;
constexpr size_t WS_N1 = WS_R + 16 * MiB;
constexpr size_t WS_O = WS_N1;
constexpr size_t WS_PROJ = WS_R + 48 * MiB;
constexpr size_t WS_Y = WS_R;
constexpr size_t WS_N2 = WS_R + 64 * MiB;
constexpr size_t WS_HID = WS_R + 96 * MiB;
constexpr size_t WS_ROUTE = WS_R + 136 * MiB;
constexpr size_t WS_RSTD = WS_ROUTE + 512 * 1024;
constexpr size_t WS_LIST = WS_R + 137 * MiB;
constexpr size_t WS_LRS = WS_R + 139 * MiB;
constexpr size_t WS_LGW = WS_R + 141 * MiB;
constexpr size_t WS_END = WS_R + 144 * MiB;
constexpr int CW_CNT = 64;

struct Route { int e0, e1; float w0, w1; };

__device__ __forceinline__ float wave_sum(float v) {
#pragma unroll
    for (int o = 1; o < 64; o <<= 1) v += __shfl_xor(v, o);
    return v;
}
__device__ __forceinline__ float logsigmoid(float z) { return fminf(z, 0.f) - log1pf(__expf(-fabsf(z))); }
#define LAS __attribute__((address_space(3)))
#define GAS __attribute__((address_space(1)))
typedef unsigned u32x4 __attribute__((ext_vector_type(4)));
typedef unsigned u32x2 __attribute__((ext_vector_type(2)));
namespace pg8 {
constexpr int BM = 256, BK = 64, HALF = 128, HTB = HALF * BK * 2, STAGE_BYTES = 8 * HTB, NXCD = 8, WGM = 8;
__host__ __device__ __forceinline__ int lds_byte(int r, int c) { const int st = (r >> 4) * 2 + (c >> 5), rr = r & 15, cc = c & 31, ob = rr * 64 + cc * 2; return st * 1024 + (ob ^ (((ob >> 9) & 1) << 5)); }
__host__ __device__ __forceinline__ void stage_rc(int b, int& R, int& C) { const int st = b / 1024, sb = b % 1024, swz = sb ^ (((sb >> 9) & 1) << 5); R = (st >> 1) * 16 + swz / 64; C = (st & 1) * 32 + (swz % 64) / 2; }
__host__ __device__ __forceinline__ int perm32(int rho) { const int n = rho >> 4, i = rho & 15; return 8 * (i >> 2) + 4 * n + (i & 3); }
struct Unit { int pm, pn, e, nrows; };
typedef float f32x2_t __attribute__((ext_vector_type(2))); typedef __bf16 bf16x2_t __attribute__((ext_vector_type(2)));
__device__ __forceinline__ unsigned cvt_pk_bf16(float lo, float hi) { const f32x2_t v = {lo, hi}; const bf16x2_t b = __builtin_convertvector(v, bf16x2_t); return __builtin_bit_cast(unsigned, b); }

__device__ __forceinline__ void st16_wt(void* p, u32x4 v) { asm volatile("global_store_dwordx4 %0, %1, off sc1\n\ts_nop 1" :: "v"(p), "v"(v) : "memory"); }

struct DenseOrder {
    int nM, nN, nwg, G, c, K; const char* A; const char* Bt;
    __device__ void init(const void* A_, const void* Bt_, int M_, int N_, int K_, int G_, int c_) { A = (const char*)A_; Bt = (const char*)Bt_; nM = M_ / BM; nN = N_ / BM; nwg = nM * nN; G = G_; c = c_; K = K_; }
    __device__ __forceinline__ bool next(int i, Unit& u) const {
        const long L = (long)i * G + c; if (L >= nwg) return false;
        int wgid = (int)L; { const int q = nwg / NXCD, r = nwg % NXCD, xcd = wgid % NXCD, off = wgid / NXCD; wgid = (xcd < r ? xcd * (q + 1) : r * (q + 1) + (xcd - r) * q) + off; }
        const int nig = WGM * nN, gid = wgid / nig, fm = gid * WGM, gsz = (nM - fm) < WGM ? (nM - fm) : WGM;
        u.pm = fm + ((wgid % nig) % gsz); u.pn = (wgid % nig) / gsz; u.e = 0; u.nrows = 256; return true;
    }
    __device__ __forceinline__ void a_off(const Unit& u, const int (&R)[2], const int (&C)[2], unsigned (&off)[2][2]) const {
#pragma unroll
        for (int h = 0; h < 2; ++h)
#pragma unroll
            for (int i = 0; i < 2; ++i) off[h][i] = (unsigned)(((u.pm * BM + h * HALF + R[i]) * K + C[i]) * 2);
    }
    __device__ __forceinline__ const char* a_base() const { return A; }
    __device__ __forceinline__ const char* b_base(const Unit& u) const { return Bt + (size_t)u.pn * BM * K * 2; }
};

template <class Base> struct RangeOrder {
    Base base; int i0, i1;
    __device__ __forceinline__ bool next(int i, Unit& u) const { return (i + i0 < i1) && base.next(i + i0, u); }
    __device__ __forceinline__ void a_off(const Unit& u, const int (&R)[2], const int (&C)[2], unsigned (&off)[2][2]) const { base.a_off(u, R, C, off); }
    __device__ __forceinline__ const char* a_base() const { return base.a_base(); }
    __device__ __forceinline__ const char* b_base(const Unit& u) const { return base.b_base(u); }
};
struct EpiBf16 {
    static constexpr bool PERM = true, AFTER_DRAIN = false;
    bf16* O; int ldc;
    __device__ __forceinline__ void operator()(const f32x4 (&acc)[2][2][4][2], const Unit& u, int wr, int wc, int fr, int fq) const {
        const int row0 = u.pm * BM + wr * 64 + fr, col0 = u.pn * BM + wc * 32 + 8 * fq;
#pragma unroll
        for (int ai = 0; ai < 2; ++ai)
#pragma unroll
            for (int m = 0; m < 4; ++m) { bf16* rowp = O + (size_t)(row0 + ai * HALF + m * 16) * ldc + col0;
#pragma unroll
                for (int bj = 0; bj < 2; ++bj) { const f32x4 v0 = acc[ai][bj][m][0], v1 = acc[ai][bj][m][1];
                    u32x4 w; w.x = cvt_pk_bf16(v0[0], v0[1]); w.y = cvt_pk_bf16(v0[2], v0[3]); w.z = cvt_pk_bf16(v1[0], v1[1]); w.w = cvt_pk_bf16(v1[2], v1[3]);
                    st16_wt(rowp + bj * HALF, w); } }
    }
};

struct EpiResBf16 {
    static constexpr bool PERM = true, AFTER_DRAIN = false;
    const float* X; bf16* H;
    __device__ __forceinline__ void operator()(const f32x4 (&acc)[2][2][4][2], const Unit& u, int wr, int wc, int fr, int fq) const {
        const int row0 = u.pm * BM + wr * 64 + fr, col0 = u.pn * BM + wc * 32 + 8 * fq;
        f32x4 xv[2][8];
#define RES_LOAD(b, dst) { _Pragma("unroll") for (int mm = 0; mm < 2; ++mm) { const float* xp = X + (size_t)(row0 + ((b) >> 1) * HALF + (2 * ((b) & 1) + mm) * 16) * D + col0; \
            _Pragma("unroll") for (int bj = 0; bj < 2; ++bj) { dst[mm * 4 + bj * 2] = __builtin_nontemporal_load((const f32x4*)(xp + bj * HALF)); dst[mm * 4 + bj * 2 + 1] = __builtin_nontemporal_load((const f32x4*)(xp + bj * HALF + 4)); } } }
        RES_LOAD(0, xv[0]);
#pragma unroll
        for (int b = 0; b < 4; ++b) {
            if (b + 1 < 4) RES_LOAD(b + 1, xv[(b + 1) & 1]);
            const int ai = b >> 1;
#pragma unroll
            for (int mm = 0; mm < 2; ++mm) { const int m = 2 * (b & 1) + mm; bf16* rowp = H + (size_t)(row0 + ai * HALF + m * 16) * D + col0;
#pragma unroll
                for (int bj = 0; bj < 2; ++bj) { const f32x4 v0 = acc[ai][bj][m][0] + xv[b & 1][mm * 4 + bj * 2], v1 = acc[ai][bj][m][1] + xv[b & 1][mm * 4 + bj * 2 + 1];
                    u32x4 w; w.x = cvt_pk_bf16(v0[0], v0[1]); w.y = cvt_pk_bf16(v0[2], v0[3]); w.z = cvt_pk_bf16(v1[0], v1[1]); w.w = cvt_pk_bf16(v1[2], v1[3]);
                    st16_wt(rowp + bj * HALF, w); } }
        }
#undef RES_LOAD
    }
};

template <class Epi, class Sched, bool ALIGN_EPI>
__device__ __forceinline__ void gemm_phase(LAS unsigned char* lds, int K, const Sched& S, const Epi& E) {
    const int tid = threadIdx.x, wid = __builtin_amdgcn_readfirstlane(tid >> 6), lane = tid & 63, wr = wid >> 2, wc = wid & 3, fr = lane & 15, fq = lane >> 4;
    const int nt = K / BK;
    int Rr[2], Cc[2]; unsigned voffB[2];
#pragma unroll
    for (int i = 0; i < 2; ++i) { int R, C; stage_rc(tid * 16 + i * 8192, R, C); const int Rb = Epi::PERM ? ((R & ~31) + perm32(R & 31)) : R; Rr[i] = R; Cc[i] = C; voffB[i] = (unsigned)(Rb * K + C) * 2u; }
    const size_t kstep = (size_t)(BK * 2);
    const size_t hstep = (size_t)HALF * K * 2;
    const unsigned ldsw = (unsigned)wid * 1024u;
    const int aoff = lds_byte(wr * 64 + fr, fq * 8), boff = lds_byte(wc * 32 + fr, fq * 8);
    const char* const Ab = S.a_base();
#define PG8_SA(b, h) (((b) * 2 + (h)) * HTB)
#define PG8_SB(b, h) ((4 + (b) * 2 + (h)) * HTB)
#define PG8_STAGE_B(bufoff, gbase) do { _Pragma("unroll") for (int _i = 0; _i < 2; ++_i) \
        __builtin_amdgcn_global_load_lds((const unsigned*)((const char*)(gbase) + voffB[_i]), (LAS unsigned*)(lds + (bufoff) + ldsw + _i * 8192), 16, 0, 0); } while (0)
#define PG8_STAGE_A(bufoff, o0, o1, kb) do { \
        __builtin_amdgcn_global_load_lds((const unsigned*)(Ab + (o0) + (kb)), (LAS unsigned*)(lds + (bufoff) + ldsw), 16, 0, 0); \
        __builtin_amdgcn_global_load_lds((const unsigned*)(Ab + (o1) + (kb)), (LAS unsigned*)(lds + (bufoff) + ldsw + 8192), 16, 0, 0); } while (0)
#define PG8_LDA(dst, b, h) do { _Pragma("unroll") for (int m = 0; m < 4; ++m) _Pragma("unroll") for (int k = 0; k < 2; ++k) dst[m][k] = *(const LAS bf16x8*)(lds + PG8_SA(b, h) + aoff + m * 2048 + k * 1024); } while (0)
#define PG8_LDB(dst, b, h) do { _Pragma("unroll") for (int n = 0; n < 2; ++n) _Pragma("unroll") for (int k = 0; k < 2; ++k) dst[n][k] = *(const LAS bf16x8*)(lds + PG8_SB(b, h) + boff + n * 2048 + k * 1024); } while (0)
#define PG8_MMA(ai, bj, At, Bt) do { __builtin_amdgcn_s_setprio(1); _Pragma("unroll") for (int m = 0; m < 4; ++m) _Pragma("unroll") for (int n = 0; n < 2; ++n) _Pragma("unroll") for (int k = 0; k < 2; ++k) \
        acc[ai][bj][m][n] = __builtin_amdgcn_mfma_f32_16x16x32_bf16(Bt[n][k], At[m][k], acc[ai][bj][m][n], 0, 0, 0); __builtin_amdgcn_s_setprio(0); } while (0)
#define PG8_WAIT_V(n) asm volatile("s_waitcnt vmcnt(" #n ")" ::: "memory")
#define PG8_WAIT_L(n) asm volatile("s_waitcnt lgkmcnt(" #n ")" ::: "memory")
#define PG8_BAR __builtin_amdgcn_s_barrier()
#define PG8_SCHED __builtin_amdgcn_sched_barrier(0)
    Unit cur, nxt; int ui = 0;
    if (!S.next(0, cur)) return;
    f32x4 acc[2][2][4][2];
#pragma unroll
    for (int a = 0; a < 2; ++a)
#pragma unroll
        for (int b = 0; b < 2; ++b)
#pragma unroll
            for (int m = 0; m < 4; ++m)
#pragma unroll
                for (int n = 0; n < 2; ++n) acc[a][b][m][n] = (f32x4){0.f, 0.f, 0.f, 0.f};
    bf16x8 At[4][2], B0[2][2], B1[2][2];
    unsigned oc[2][2], on[2][2];
    S.a_off(cur, Rr, Cc, oc);
    const char* cB = S.b_base(cur);
    PG8_STAGE_B(PG8_SB(0, 0), cB); PG8_STAGE_B(PG8_SB(0, 1), cB + hstep); PG8_STAGE_A(PG8_SA(0, 0), oc[0][0], oc[0][1], 0); PG8_STAGE_A(PG8_SA(0, 1), oc[1][0], oc[1][1], 0);
    if (wr == 1) PG8_BAR;
    PG8_WAIT_V(2); PG8_BAR;
    PG8_STAGE_B(PG8_SB(1, 0), cB + kstep); PG8_STAGE_A(PG8_SA(1, 0), oc[0][0], oc[0][1], kstep); PG8_STAGE_B(PG8_SB(1, 1), cB + hstep + kstep);
    PG8_WAIT_V(6); PG8_BAR;
    for (;;) {
        const bool has_next = S.next(ui + 1, nxt);
        const char* nB = cB;
        if (has_next) { S.a_off(nxt, Rr, Cc, on); nB = S.b_base(nxt); }
        else {
#pragma unroll
            for (int h = 0; h < 2; ++h)
#pragma unroll
                for (int i = 0; i < 2; ++i) on[h][i] = oc[h][i]; }
        for (int t = 0; t < nt; t += 2) {
            const bool last = (t == nt - 2);
            const size_t k1 = (size_t)(t + 1) * kstep;
            const size_t k2 = last ? 0 : (size_t)(t + 2) * kstep, k3 = k2 + kstep;
            const char* b2 = last ? nB : cB + (size_t)(t + 2) * kstep; const char* b3 = b2 + kstep;
            const unsigned a20 = last ? on[0][0] : oc[0][0], a21 = last ? on[0][1] : oc[0][1], a30 = last ? on[1][0] : oc[1][0], a31 = last ? on[1][1] : oc[1][1];
            PG8_LDB(B0, 0, 0); PG8_LDB(B1, 0, 1); PG8_SCHED; PG8_LDA(At, 0, 0); PG8_STAGE_A(PG8_SA(1, 1), oc[1][0], oc[1][1], k1);
            PG8_WAIT_V(8); PG8_WAIT_L(0); PG8_BAR; PG8_MMA(0, 0, At, B0); PG8_MMA(0, 1, At, B1); PG8_BAR; PG8_SCHED;
            PG8_LDA(At, 0, 1); PG8_STAGE_B(PG8_SB(0, 0), b2); PG8_STAGE_B(PG8_SB(0, 1), b2 + hstep); PG8_STAGE_A(PG8_SA(0, 0), a20, a21, k2);
            PG8_WAIT_V(8); PG8_WAIT_L(0); PG8_BAR; PG8_MMA(1, 0, At, B0); PG8_MMA(1, 1, At, B1); PG8_BAR; PG8_SCHED;
            PG8_LDB(B0, 1, 0); PG8_LDB(B1, 1, 1); PG8_SCHED; PG8_LDA(At, 1, 0); PG8_STAGE_A(PG8_SA(0, 1), a30, a31, k2);
            PG8_WAIT_V(8); PG8_WAIT_L(0); PG8_BAR; PG8_MMA(0, 0, At, B0); PG8_MMA(0, 1, At, B1); PG8_BAR; PG8_SCHED;
            PG8_LDA(At, 1, 1); PG8_STAGE_B(PG8_SB(1, 0), b3); PG8_STAGE_B(PG8_SB(1, 1), b3 + hstep); PG8_STAGE_A(PG8_SA(1, 0), a20, a21, k3);
            PG8_WAIT_V(8); PG8_WAIT_L(0); PG8_BAR; PG8_MMA(1, 0, At, B0); PG8_MMA(1, 1, At, B1); PG8_BAR; PG8_SCHED;
        }
        if constexpr (ALIGN_EPI) { if (wr == 0) PG8_BAR; }
        if constexpr (!Epi::AFTER_DRAIN) E(acc, cur, wr, wc, fr, fq);
        if (!has_next) break;
#pragma unroll
        for (int a = 0; a < 2; ++a)
#pragma unroll
            for (int b = 0; b < 2; ++b)
#pragma unroll
                for (int m = 0; m < 4; ++m)
#pragma unroll
                    for (int n = 0; n < 2; ++n) acc[a][b][m][n] = (f32x4){0.f, 0.f, 0.f, 0.f};
        cur = nxt; cB = nB; ++ui;
#pragma unroll
        for (int h = 0; h < 2; ++h)
#pragma unroll
            for (int i = 0; i < 2; ++i) oc[h][i] = on[h][i];
        if constexpr (ALIGN_EPI) { if (wr == 1) PG8_BAR; }
    }
    PG8_WAIT_V(0);
    if constexpr (!ALIGN_EPI) { if (wr == 0) PG8_BAR; }
    PG8_BAR;
    if constexpr (Epi::AFTER_DRAIN) E.fused(acc, cur, wr, wc, fr, fq, lds, wid, lane);
#undef PG8_SA
#undef PG8_SB
#undef PG8_STAGE_A
#undef PG8_STAGE_B
#undef PG8_LDA
#undef PG8_LDB
#undef PG8_MMA
#undef PG8_WAIT_V
#undef PG8_WAIT_L
#undef PG8_BAR
#undef PG8_SCHED
}
}
constexpr int NWAVES = 8, NTHREADS = NWAVES * 64;
constexpr int RING_BYTES = 131072;
constexpr int LDS_BYTES = 163840;
constexpr int LDSCTL_OFF = 162816;
constexpr int CW_BAR = 4096;
typedef GAS unsigned gu32;
#define RLX_AGENT __ATOMIC_RELAXED, __HIP_MEMORY_SCOPE_AGENT
#define LDS_WAIT() asm volatile("s_waitcnt lgkmcnt(0)" ::: "memory")
#define VM_WAIT() asm volatile("s_waitcnt vmcnt(0)" ::: "memory")
__device__ __forceinline__ unsigned pk2(float lo, float hi) { return pg8::cvt_pk_bf16(lo, hi); }

#define XB_TMO      128
#define XB_XCNT(j)  (256  + 64 * (j))
#define XB_XSUB(j)  (1280 + 64 * (j))
#define XB_XGEN(j)  (2304 + 64 * (j))
#define XB_TOP      3328
#define XB_TOPGEN   3392
#define XCD_BAR_WORDS 3456
#define XB_SPIN_CAP (1u << 18)
__device__ __forceinline__ unsigned xb_ld(unsigned* p)              { return __hip_atomic_load(p, __ATOMIC_RELAXED, __HIP_MEMORY_SCOPE_AGENT); }
__device__ __forceinline__ unsigned xb_add(unsigned* p, unsigned v) { return __hip_atomic_fetch_add(p, v, __ATOMIC_RELAXED, __HIP_MEMORY_SCOPE_AGENT); }
__device__ __forceinline__ unsigned xb_xcc_id() { return (unsigned)__builtin_amdgcn_s_getreg((3 << 11) | 20) & 0xFu; }
#define XB_SPIN(cond, bar) do { unsigned _sp = 0; while (cond) { __builtin_amdgcn_s_sleep(1); \
    if ((++_sp & 255u) == 0u) { if (xb_ld(&(bar)[XB_TMO])) break; if (_sp > XB_SPIN_CAP) { atomicAdd(&(bar)[XB_TMO], 1u); break; } } } } while (0)
struct XcdBarrier { unsigned* bar; unsigned x; volatile LAS unsigned* st; };
__device__ __forceinline__ XcdBarrier xcd_barrier_post(unsigned* bar, volatile LAS unsigned* st) {
    XcdBarrier b; b.bar = bar; b.x = xb_xcc_id(); b.st = st;
    if (threadIdx.x == 0) (void)xb_add(&bar[XB_XCNT(b.x)], 1u);
    return b;
}
__device__ __forceinline__ void xcd_barrier_complete(unsigned* bar, unsigned x, unsigned& nloc, unsigned& nx) {
    const unsigned G = gridDim.x * gridDim.y * gridDim.z;
    unsigned sum, cnt, mine, sp = 0u;
    for (;;) {
        sum = 0u; cnt = 0u; mine = 0u;
#pragma unroll
        for (unsigned j = 0; j < 16; ++j) { const unsigned c = xb_ld(&bar[XB_XCNT(j)]); sum += c; cnt += (c > 0u) ? 1u : 0u; mine = (j == x) ? c : mine; }
        if (sum == G) break;
        __builtin_amdgcn_s_sleep(1);
        if ((++sp & 255u) == 0u) { if (xb_ld(&bar[XB_TMO])) break; if (sp > XB_SPIN_CAP) { atomicAdd(&bar[XB_TMO], 1u); break; } }
    }
    nloc = mine > 0u ? mine : 1u; nx = cnt > 0u ? cnt : 1u;
}
__device__ __forceinline__ void xcd_barrier(const XcdBarrier& b) {
    asm volatile("s_waitcnt vmcnt(0)" ::: "memory");
    __syncthreads();
    if (threadIdx.x == 0) {
        unsigned* bar = b.bar;
        __builtin_amdgcn_s_waitcnt(0);
        unsigned nloc = b.st[0], nx = b.st[1];
        if (nloc == 0u) { xcd_barrier_complete(bar, b.x, nloc, nx); b.st[0] = nloc; b.st[1] = nx; }
        const unsigned old = xb_add(&bar[XB_XSUB(b.x)], 1u);
        const unsigned gen = old / nloc;
        if (old + 1u == (gen + 1u) * nloc) {
            __builtin_amdgcn_fence(__ATOMIC_RELEASE, "agent");
            asm volatile("s_waitcnt vmcnt(0)" ::: "memory");
            const unsigned og = xb_add(&bar[XB_TOP], 1u);
            const unsigned tg = og / nx;
            if (og + 1u == (tg + 1u) * nx) xb_add(&bar[XB_TOPGEN], 1u);
            else XB_SPIN(xb_ld(&bar[XB_TOPGEN]) == tg, bar);
            __builtin_amdgcn_fence(__ATOMIC_ACQUIRE, "agent");
            xb_add(&bar[XB_XGEN(b.x)], 1u);
            asm volatile("s_waitcnt vmcnt(0)" ::: "memory");
        } else {
            XB_SPIN(xb_ld(&bar[XB_XGEN(b.x)]) == gen, bar);
            __builtin_amdgcn_fence(__ATOMIC_ACQUIRE, "agent");
            asm volatile("s_waitcnt vmcnt(0)" ::: "memory");
        }
    }
    __syncthreads();
}

struct Args { const float* in[16]; float* out; unsigned char* ws; int ph_lo, ph_hi; };

template <bool SC>
__device__ __forceinline__ void tr_item(const float* src, int ld, bf16* dst, int K, LAS float* scr, int lane, const float* gk = nullptr) {
#pragma unroll 16
    for (int i = 0; i < 32; ++i) { const int kk = 2 * i + (lane >> 5); scr[kk * 33 + (lane & 31)] = __builtin_nontemporal_load(src + (size_t)kk * ld + (lane & 31)); }
    LDS_WAIT(); asm volatile("" ::: "memory");
    const int c = lane & 7;
    f32x4 g0 = {1.f, 1.f, 1.f, 1.f}, g1 = g0;
    if (SC) { g0 = *(const f32x4*)(gk + 8 * c); g1 = *(const f32x4*)(gk + 8 * c + 4); }
#pragma unroll
    for (int j = 0; j < 4; ++j) { const int n = (lane >> 3) + 8 * j; const LAS float* s = scr + (8 * c) * 33 + n;
        u32x4 o;
        if (SC) { o.x = pk2(s[0 * 33] * g0.x, s[1 * 33] * g0.y); o.y = pk2(s[2 * 33] * g0.z, s[3 * 33] * g0.w); o.z = pk2(s[4 * 33] * g1.x, s[5 * 33] * g1.y); o.w = pk2(s[6 * 33] * g1.z, s[7 * 33] * g1.w); }
        else { o.x = pk2(s[0 * 33], s[1 * 33]); o.y = pk2(s[2 * 33], s[3 * 33]); o.z = pk2(s[4 * 33], s[5 * 33]); o.w = pk2(s[6 * 33], s[7 * 33]); }
        __builtin_nontemporal_store(o, (GAS u32x4*)(dst + (size_t)n * K + 8 * c)); }
    LDS_WAIT(); asm volatile("" ::: "memory");
}
__device__ __forceinline__ float wave_reduce16(const float (&p)[16], int lane) {
    float a[8], b[4], c[2], d;
    { const bool hi = lane & 32;
#pragma unroll
      for (int i = 0; i < 8; ++i) { const float mine = hi ? p[i + 8] : p[i], theirs = hi ? p[i] : p[i + 8]; a[i] = mine + __shfl_xor(theirs, 32); } }
    { const bool hi = lane & 16;
#pragma unroll
      for (int i = 0; i < 4; ++i) { const float mine = hi ? a[i + 4] : a[i], theirs = hi ? a[i] : a[i + 4]; b[i] = mine + __shfl_xor(theirs, 16); } }
    { const bool hi = lane & 8;
#pragma unroll
      for (int i = 0; i < 2; ++i) { const float mine = hi ? b[i + 2] : b[i], theirs = hi ? b[i] : b[i + 2]; c[i] = mine + __shfl_xor(theirs, 8); } }
    { const bool hi = lane & 4; const float mine = hi ? c[1] : c[0], theirs = hi ? c[0] : c[1]; d = mine + __shfl_xor(theirs, 4); }
    d += __shfl_xor(d, 1); d += __shfl_xor(d, 2);
    return d;
}
__device__ __forceinline__ void p0_prologue(const Args& a, LAS unsigned char* lds, int vcu, int G) {
    const int tid = threadIdx.x, lane = tid & 63, wave = __builtin_amdgcn_readfirstlane(tid >> 6);
    unsigned char* ws = a.ws;
    const float* w_in = a.in[2]; const float* w_out = a.in[6]; const float* ew1 = a.in[12]; const float* ew3 = a.in[13]; const float* ew2 = a.in[14];
    bf16* WinT = (bf16*)(ws + WS_WIN); bf16* WoutT = (bf16*)(ws + WS_WOUT); bf16* W13T = (bf16*)(ws + WS_W13); bf16* W2T = (bf16*)(ws + WS_W2);
    const int gw = vcu * NWAVES + wave, NGW = G * NWAVES;
    {
        LAS float* wl = (LAS float*)(lds + 67584);
        for (int k = tid; k < D; k += NTHREADS) { const int slot = ((k & 3) + 4 * (k >> 8)) * 64 + ((k >> 2) & 63); const float* src = w_in + (size_t)k * INC + GLR_SRC;
#pragma unroll
            for (int q = 0; q < 4; ++q) *(LAS f32x4*)(wl + slot * 20 + 4 * q) = *(const f32x4*)(src + 4 * q); }
    }
    __syncthreads();
    {
        const float* x = a.in[0]; const float* g1 = a.in[1]; bf16* N1 = (bf16*)(ws + WS_N1); float* GLR = (float*)(ws + WS_GLR);
        const LAS float* wl = (const LAS float*)(lds + 67584);
        f32x4 g[4];
#pragma unroll
        for (int j = 0; j < 4; ++j) g[j] = ((const f32x4*)g1)[lane + 64 * j];
        f32x4 nv[4];
        if (gw < M) {
#pragma unroll
            for (int j = 0; j < 4; ++j) nv[j] = __builtin_nontemporal_load((const f32x4*)(x + (size_t)gw * D) + lane + 64 * j); }
#pragma unroll 1
        for (int m = gw; m < M; m += NGW) {
            f32x4 v[4]; float s = 0.f;
#pragma unroll
            for (int j = 0; j < 4; ++j) v[j] = nv[j];
            if (m + NGW < M) {
#pragma unroll
                for (int j = 0; j < 4; ++j) nv[j] = __builtin_nontemporal_load((const f32x4*)(x + (size_t)(m + NGW) * D) + lane + 64 * j); }
#pragma unroll
            for (int j = 0; j < 4; ++j) { s += (v[j].x * v[j].x + v[j].y * v[j].y) + (v[j].z * v[j].z + v[j].w * v[j].w); }
            const float rstd = rsqrtf(wave_sum(s) * (1.f / D) + EPS);
            GAS u32x2* o8 = (GAS u32x2*)(N1 + (size_t)m * D) + lane;
            float p[16];
#pragma unroll
            for (int r = 0; r < 16; ++r) p[r] = 0.f;
#pragma unroll
            for (int j = 0; j < 4; ++j) { v[j] = v[j] * rstd * g[j]; u32x2 w; w.x = pk2(v[j].x, v[j].y); w.y = pk2(v[j].z, v[j].w); o8[64 * j] = w;
#pragma unroll
                for (int jj = 0; jj < 4; ++jj) { const LAS float* wr = wl + ((jj + 4 * j) * 64 + lane) * 20; const float xv = v[j][jj];
#pragma unroll
                    for (int q = 0; q < 4; ++q) { const f32x4 wv = *(const LAS f32x4*)(wr + 4 * q); p[4 * q] += xv * wv.x; p[4 * q + 1] += xv * wv.y; p[4 * q + 2] += xv * wv.z; p[4 * q + 3] += xv * wv.w; }
                    if (jj & 1) asm volatile("" ::: "memory"); } }
            const float tot = wave_reduce16(p, lane);
            if ((lane & 3) == 0) GLR[(size_t)m * 16 + ((lane >> 2) & 15)] = tot;
        }
    }
    { const float* wg = a.in[8]; const float* we = a.in[10]; bf16* WRT = (bf16*)(ws + WS_WRT);
      for (int idx = gw * 64 + lane; idx < D * 36; idx += NGW * 64) { const int k = idx / 36, col = idx % 36; const float wv = (col < 4 ? wg[k * 4 + col] : we[k * 32 + col - 4]) * a.in[7][k];
          const bf16 hi = f2bf(wv), lo = f2bf(wv - bf2f(hi)); const int o = ((((k >> 5) * 2) * 36 + col) * 4 + ((k >> 3) & 3)) * 8 + (k & 7); WRT[o] = hi; WRT[o + 36 * 4 * 8] = lo; } }
    {
        LAS float* scr = (LAS float*)(lds + wave * 8448);
        constexpr int I_IN = 16 * 96, I_OUT = 16 * 32, NITEMS = I_IN + I_OUT;
        for (int it = gw; it < NITEMS; it += NGW) {
            int r = it;
            if (r < I_IN) { const int kb = r / 96, n0 = 32 * (r % 96); tr_item<false>(w_in + (size_t)(64 * kb) * INC + (n0 < 1536 ? n0 : n0 + 16), INC, WinT + (size_t)n0 * D + 64 * kb, D, scr, lane); continue; } r -= I_IN;
            { const int kb = r / 32, n0 = 32 * (r % 32); tr_item<false>(w_out + (size_t)(64 * kb) * D + n0, D, WoutT + (size_t)n0 * D + 64 * kb, D, scr, lane); }
        }
    }
}
struct TrDesc { const float* src; bf16* dst; const float* gk; int ld, K; };
__device__ __forceinline__ TrDesc expert_item(const Args& a, int r) {
    constexpr int I_13 = NE * 16 * 32; TrDesc d;
    if (r < I_13) { const int e = r / 512, q = r % 512, kb = q / 32, n0 = 32 * (q % 32); const float* w = ((n0 >> 7) & 1) ? a.in[13] : a.in[12];
        d.src = w + ((size_t)e * D + 64 * kb) * FF + 128 * (n0 >> 8) + (n0 & 127); d.ld = FF; d.dst = (bf16*)(a.ws + WS_W13) + (size_t)e * D * D + (size_t)n0 * D + 64 * kb; d.K = D; d.gk = a.in[7] + 64 * kb; }
    else { r -= I_13; const int e = r / 256, q = r % 256, kb = q / 32, n0 = 32 * (q % 32);
        d.src = a.in[14] + ((size_t)e * FF + 64 * kb) * D + n0; d.ld = D; d.dst = (bf16*)(a.ws + WS_W2) + (size_t)e * D * FF + (size_t)n0 * FF + 64 * kb; d.K = FF; d.gk = nullptr; }
    return d;
}
__device__ __forceinline__ void tr_fetch(const TrDesc& d, int lane, f32x4 (&r)[8], f32x4& g0, f32x4& g1) {
#pragma unroll
    for (int i = 0; i < 8; ++i) r[i] = __builtin_nontemporal_load((const f32x4*)(d.src + (size_t)(8 * i + (lane >> 3)) * d.ld + 4 * (lane & 7)));
    g0 = (f32x4){1.f, 1.f, 1.f, 1.f}; g1 = g0;
    if (d.gk) { g0 = *(const f32x4*)(d.gk + 8 * (lane & 7)); g1 = *(const f32x4*)(d.gk + 8 * (lane & 7) + 4); }
}
__device__ __forceinline__ void tr_finish(const TrDesc& d, int lane, const f32x4 (&r)[8], const f32x4 g0, const f32x4 g1, LAS float* scr) {
#pragma unroll
    for (int i = 0; i < 8; ++i) { LAS float* w = scr + (8 * i + (lane >> 3)) * 33 + 4 * (lane & 7); w[0] = r[i].x; w[1] = r[i].y; w[2] = r[i].z; w[3] = r[i].w; }
    LDS_WAIT(); asm volatile("" ::: "memory");
    const int c = lane & 7;
#pragma unroll
    for (int j = 0; j < 4; ++j) { const int n = (lane >> 3) + 8 * j; const LAS float* s = scr + (8 * c) * 33 + n;
        u32x4 o; o.x = pk2(s[0 * 33] * g0.x, s[1 * 33] * g0.y); o.y = pk2(s[2 * 33] * g0.z, s[3 * 33] * g0.w); o.z = pk2(s[4 * 33] * g1.x, s[5 * 33] * g1.y); o.w = pk2(s[6 * 33] * g1.z, s[7 * 33] * g1.w);
        __builtin_nontemporal_store(o, (GAS u32x4*)(d.dst + (size_t)n * d.K + 8 * c)); }
    LDS_WAIT(); asm volatile("" ::: "memory");
}
__device__ __forceinline__ void p0_expert_items(const Args& a, LAS unsigned char* lds, int first, int stride, int end) {
    const int lane = threadIdx.x & 63, wave = __builtin_amdgcn_readfirstlane(threadIdx.x >> 6);
    LAS float* scr = (LAS float*)(lds + wave * 8448);
    f32x4 r[4][8], g[4][2]; TrDesc d[4];
#pragma unroll
    for (int j = 0; j < 3; ++j) { const int it = first + j * stride; if (it < end) { d[j] = expert_item(a, it); tr_fetch(d[j], lane, r[j], g[j][0], g[j][1]); } }
#pragma unroll 1
    for (int it = first; it < end; it += 4 * stride) {
#pragma unroll
        for (int j = 0; j < 4; ++j) {
            const int cur = it + j * stride, nx = cur + 3 * stride;
            if (nx < end) { d[(j + 3) & 3] = expert_item(a, nx); tr_fetch(d[(j + 3) & 3], lane, r[(j + 3) & 3], g[(j + 3) & 3][0], g[(j + 3) & 3][1]); }
            if (cur < end) tr_finish(d[j], lane, r[j], g[j][0], g[j][1], scr);
        }
    }
}
__device__ __forceinline__ void p8_final(const Args& a, int vcu, int G, float* dst) {
    const int tid = threadIdx.x, lane = tid & 63, wave = __builtin_amdgcn_readfirstlane(tid >> 6);
    const int gw = vcu * NWAVES + wave, NGW = G * NWAVES;
    const bf16* Y = (const bf16*)(a.ws + WS_Y); float* out = a.out; const float* gf = a.in[15];
    f32x4 g[4];
#pragma unroll
    for (int j = 0; j < 4; ++j) g[j] = ((const f32x4*)gf)[lane + 64 * j];
#pragma unroll 1
    for (int m = gw; m < M; m += NGW) {
        const u32x2* hr = (const u32x2*)((const bf16*)(a.ws + WS_N2) + (size_t)m * D) + lane;
        const u32x2* y0 = (const u32x2*)(Y + (size_t)(2 * m) * D) + lane; const u32x2* y1 = y0 + D / 4;
        f32x4 v[4]; float s = 0.f;
#pragma unroll
        for (int j = 0; j < 4; ++j) { const u32x2 tv = __builtin_nontemporal_load(hr + 64 * j), p = __builtin_nontemporal_load(y0 + 64 * j), q = __builtin_nontemporal_load(y1 + 64 * j);
            v[j].x = __uint_as_float(tv.x << 16); v[j].y = __uint_as_float(tv.x & 0xffff0000u); v[j].z = __uint_as_float(tv.y << 16); v[j].w = __uint_as_float(tv.y & 0xffff0000u);
            v[j].x += __uint_as_float(p.x << 16) + __uint_as_float(q.x << 16); v[j].y += __uint_as_float(p.x & 0xffff0000u) + __uint_as_float(q.x & 0xffff0000u);
            v[j].z += __uint_as_float(p.y << 16) + __uint_as_float(q.y << 16); v[j].w += __uint_as_float(p.y & 0xffff0000u) + __uint_as_float(q.y & 0xffff0000u);
            s += (v[j].x * v[j].x + v[j].y * v[j].y) + (v[j].z * v[j].z + v[j].w * v[j].w); }
        const float rstd = rsqrtf(wave_sum(s) * (1.f / D) + EPS);
#pragma unroll
        for (int j = 0; j < 4; ++j) __builtin_nontemporal_store(v[j] * rstd * g[j], (f32x4*)(dst + (size_t)m * D) + lane + 64 * j);
    }
}

constexpr int LDS_PB = LDSCTL_OFF + 128;
constexpr int LDS_CNT = LDSCTL_OFF + 384;
constexpr int LDS_LCNT = 147456, LDS_LBASE = 147584, LDS_REC = 147712, REC_ITERS = 4;
constexpr int LDS_REX = 149760, REX_BYTES = 3200;
constexpr int CNT_STRIDE = 64;
__device__ __forceinline__ void p5_router(const Args& a, LAS unsigned char* lds, int vcu, int G) {
    const int tid = threadIdx.x, lane = tid & 63, wave = __builtin_amdgcn_readfirstlane(tid >> 6), fr = lane & 15, fq = lane >> 4, pr = wave >> 1, half = wave & 1;
    unsigned char* ws = a.ws;
    const float* bgp = a.in[9]; const float* be = a.in[11];
    const bf16* N2 = (const bf16*)(ws + WS_N2); float* RSTD = (float*)(ws + WS_RSTD); Route* ROUTE = (Route*)(ws + WS_ROUTE); int* LIST = (int*)(ws + WS_LIST);
    unsigned* cnt = (unsigned*)(ws + WS_CTL) + CW_CNT;
    { const u32x4* src = (const u32x4*)(ws + WS_WRT); LAS u32x4* dst = (LAS u32x4*)lds;
      for (int i = tid; i < 147456 / 16; i += NTHREADS) dst[i] = src[i]; }
    if (tid < NE) ((LAS unsigned*)(lds + LDS_LCNT))[tid] = 0u;
    __syncthreads();
    LAS unsigned* lcnt = (LAS unsigned*)(lds + LDS_LCNT); LAS unsigned* lbase = (LAS unsigned*)(lds + LDS_LBASE); LAS unsigned* rec = (LAS unsigned*)(lds + LDS_REC) + pr * (REC_ITERS * 32);
    LAS unsigned char* ex = lds + LDS_REX + pr * REX_BYTES; LAS float* lg = (LAS float*)ex;
    const int niter = (M / 16 + G * 4 - 1) / (G * 4);
#pragma unroll 1
    for (int it = 0; it < niter; ++it) {
        const int tile = vcu * 4 + pr + it * G * 4; const bool live = tile < M / 16;
        f32x4 acc[3]; acc[0] = (f32x4){0.f, 0.f, 0.f, 0.f}; acc[1] = acc[0]; acc[2] = acc[0]; float ssq = 0.f;
        if (live) {
            const int row = tile * 16 + fr;
            const bf16* hr = N2 + (size_t)row * D + 8 * fq + 512 * half;
            const LAS unsigned char* tb = lds + (fr * 4 + fq) * 16 + half * 16 * (2 * 36 * 64);
            const int o2 = ((32 + (fr & 3)) * 4 + fq) * 16 - (fr * 4 + fq) * 16;
            u32x4 ta[16];
#pragma unroll
            for (int s = 0; s < 16; ++s) ta[s] = __builtin_nontemporal_load((const u32x4*)(hr + 32 * s));
#pragma unroll
            for (int s = 0; s < 16; ++s) { const u32x4 tv = ta[s];
                const float hv[8] = {__uint_as_float(tv.x << 16), __uint_as_float(tv.x & 0xffff0000u), __uint_as_float(tv.y << 16), __uint_as_float(tv.y & 0xffff0000u),
                                     __uint_as_float(tv.z << 16), __uint_as_float(tv.z & 0xffff0000u), __uint_as_float(tv.w << 16), __uint_as_float(tv.w & 0xffff0000u)};
#pragma unroll
                for (int j = 0; j < 8; ++j) ssq += hv[j] * hv[j];
                const bf16x8 ah = __builtin_bit_cast(bf16x8, tv);
                const LAS unsigned char* th = tb + s * (2 * 36 * 64); const LAS unsigned char* tl = th + 36 * 64;
#pragma unroll
                for (int ct = 0; ct < 3; ++ct) { const int o = ct < 2 ? ct * 1024 : o2;
                    const bf16x8 bh = *(const LAS bf16x8*)(th + o), bl = *(const LAS bf16x8*)(tl + o);
                    acc[ct] = __builtin_amdgcn_mfma_f32_16x16x32_bf16(ah, bh, acc[ct], 0, 0, 0);
                    acc[ct] = __builtin_amdgcn_mfma_f32_16x16x32_bf16(ah, bl, acc[ct], 0, 0, 0); }
            }
            ssq += __shfl_xor(ssq, 16); ssq += __shfl_xor(ssq, 32);
            if (half) {
#pragma unroll
                for (int ct = 0; ct < 3; ++ct) *(LAS f32x4*)(ex + (ct * 64 + lane) * 16) = acc[ct];
                if (lane < 16) *(LAS float*)(ex + 3072 + lane * 4) = ssq; }
        }
        __syncthreads();
        if (live && !half) {
#pragma unroll
            for (int ct = 0; ct < 3; ++ct) acc[ct] += *(const LAS f32x4*)(ex + (ct * 64 + lane) * 16);
            ssq += *(const LAS float*)(ex + 3072 + fr * 4);
            const float rstd = rsqrtf(ssq * (1.f / D) + EPS);
            LDS_WAIT(); asm volatile("" ::: "memory");
#pragma unroll
            for (int ct = 0; ct < 3; ++ct)
#pragma unroll
                for (int r = 0; r < 4; ++r) { const int col = 16 * ct + fr; if (col < 36) lg[(4 * fq + r) * 36 + col] = acc[ct][r]; }
            LDS_WAIT(); asm volatile("" ::: "memory");
            if (lane < 16) {
                const LAS float* l = lg + 36 * lane; const int rw = tile * 16 + lane;
                int gi = 0; float gmax = l[0] * rstd + bgp[0];
                for (int c = 1; c < 4; ++c) { const float v = l[c] * rstd + bgp[c]; if (v > gmax) { gmax = v; gi = c; } }
                float den = 0.f; for (int c = 0; c < 4; ++c) den += __expf(l[c] * rstd + bgp[c] - gmax);
                const float gprob = 1.f / den;
                float b0 = -INFINITY, b1 = -INFINITY; int i0 = 0, i1 = 0;
                for (int c = 0; c < 8; ++c) { const float v = l[4 + gi * 8 + c] * rstd + be[gi * 8 + c]; if (v > b0) { b1 = b0; i1 = i0; b0 = v; i0 = c; } else if (v > b1) { b1 = v; i1 = c; } }
                const float e1x = __expf(b1 - b0); const float w0 = gprob / (1.f + e1x), w1 = gprob * e1x / (1.f + e1x);
                Route r; r.e0 = gi * 8 + i0; r.e1 = gi * 8 + i1; r.w0 = w0; r.w1 = w1; ROUTE[rw] = r; RSTD[rw] = rstd;
                const unsigned q0 = __hip_atomic_fetch_add(lcnt + r.e0, 1u, __ATOMIC_RELAXED, __HIP_MEMORY_SCOPE_WORKGROUP), q1 = __hip_atomic_fetch_add(lcnt + r.e1, 1u, __ATOMIC_RELAXED, __HIP_MEMORY_SCOPE_WORKGROUP);
                if (it < REC_ITERS) { rec[it * 32 + lane * 2] = ((unsigned)r.e0 << 16) | q0; rec[it * 32 + lane * 2 + 1] = ((unsigned)r.e1 << 16) | q1; }
            }
        }
        __syncthreads();
    }
    if (tid < NE) lbase[tid] = atomicAdd(&cnt[tid * CNT_STRIDE], lcnt[tid]);
    __syncthreads();
    if (!half && lane < 16) {
#pragma unroll 1
        for (int it = 0; it < niter && it < REC_ITERS; ++it) { const int tile = vcu * 4 + pr + it * G * 4; if (tile >= M / 16) break; const int rw = tile * 16 + lane;
            const Route rtw = ROUTE[rw]; const float rsw = RSTD[rw];
#pragma unroll
            for (int j = 0; j < 2; ++j) { const unsigned rc = rec[it * 32 + lane * 2 + j]; const int e = (int)(rc >> 16), idx = e * LIST_CAP + (int)(lbase[e] + (rc & 0xffffu));
                LIST[idx] = rw * 2 + j; ((float*)(ws + WS_LRS))[idx] = rsw; ((float*)(ws + WS_LGW))[idx] = j ? rtw.w1 : rtw.w0; } } }
}
constexpr int CW_PANEL = 16384;
constexpr int XB_COLS = 40, SLAB_PITCH = 132;
struct EpiResRouter {
    static constexpr bool PERM = true, AFTER_DRAIN = true;
    const float* X; bf16* H; unsigned char* ws; const float* bgp; const float* be;
    __device__ __forceinline__ void fused(const f32x4 (&acc)[2][2][4][2], const pg8::Unit& u, int wr, int wc, int fr, int fq, LAS unsigned char* lds, int wid, int lane) const {
        const int tid = threadIdx.x;
        const int row0 = u.pm * 256 + wr * 64 + fr, col0 = u.pn * 256 + wc * 32 + 8 * fq;
        unsigned* ctl = (unsigned*)(ws + WS_CTL);
        float ssq[2][4]; u32x4 pk[2][4][2];
        { f32x4 xv[3][8];
#define RR_LOAD(b, dst) { _Pragma("unroll") for (int mm = 0; mm < 2; ++mm) { const float* xp = X + (size_t)(row0 + ((b) >> 1) * 128 + (2 * ((b) & 1) + mm) * 16) * D + col0; \
            _Pragma("unroll") for (int bj = 0; bj < 2; ++bj) { dst[mm * 4 + bj * 2] = __builtin_nontemporal_load((const f32x4*)(xp + bj * 128)); dst[mm * 4 + bj * 2 + 1] = __builtin_nontemporal_load((const f32x4*)(xp + bj * 128 + 4)); } } }
          RR_LOAD(0, xv[0]); RR_LOAD(1, xv[1]);
#pragma unroll
          for (int b = 0; b < 4; ++b) {
              if (b + 2 < 4) RR_LOAD(b + 2, xv[(b + 2) % 3]);
              const int ai = b >> 1;
#pragma unroll
              for (int mm = 0; mm < 2; ++mm) { const int m = 2 * (b & 1) + mm; float sq = 0.f; bf16* rowp = H + (size_t)(row0 + ai * 128 + m * 16) * D + col0;
#pragma unroll
                  for (int bj = 0; bj < 2; ++bj) { const f32x4 v0 = acc[ai][bj][m][0] + xv[b % 3][mm * 4 + bj * 2], v1 = acc[ai][bj][m][1] + xv[b % 3][mm * 4 + bj * 2 + 1];
                      u32x4 w; w.x = pg8::cvt_pk_bf16(v0[0], v0[1]); w.y = pg8::cvt_pk_bf16(v0[2], v0[3]); w.z = pg8::cvt_pk_bf16(v1[0], v1[1]); w.w = pg8::cvt_pk_bf16(v1[2], v1[3]);
                      pg8::st16_wt(rowp + bj * 128, w); pk[ai][m][bj] = w;
#pragma unroll
                      for (int q = 0; q < 4; ++q) { const float lo = __uint_as_float(w[q] << 16), hi = __uint_as_float(w[q] & 0xffff0000u); sq += lo * lo + hi * hi; } }
                  ssq[ai][m] = sq; } }
#undef RR_LOAD
        }
        asm volatile("" ::: "memory");
        bf16x8 bfr[2][3][2];
        { const unsigned char* WRT = ws + WS_WRT;
#pragma unroll
          for (int bj = 0; bj < 2; ++bj) { const int kb = u.pn * 8 + bj * 4 + wc;
#pragma unroll
              for (int ct = 0; ct < 3; ++ct) { const int c = ct < 2 ? 16 * ct + fr : 32 + (fr & 3);
#pragma unroll
                  for (int hl = 0; hl < 2; ++hl) bfr[bj][ct][hl] = *(const bf16x8*)(WRT + (size_t)kb * 4608 + hl * 2304 + (c * 4 + fq) * 16); } } }
        LAS float* slab = (LAS float*)lds;
        float* XBf = (float*)(ws + WS_HID);
#pragma unroll
        for (int ai = 0; ai < 2; ++ai) {
#pragma unroll
            for (int m = 0; m < 4; ++m) {
                f32x4 al[3]; al[0] = (f32x4){0.f, 0.f, 0.f, 0.f}; al[1] = al[0]; al[2] = al[0];
#pragma unroll
                for (int bj = 0; bj < 2; ++bj) { const bf16x8 af = __builtin_bit_cast(bf16x8, pk[ai][m][bj]);
#pragma unroll
                    for (int ct = 0; ct < 3; ++ct) { al[ct] = __builtin_amdgcn_mfma_f32_16x16x32_bf16(af, bfr[bj][ct][0], al[ct], 0, 0, 0); al[ct] = __builtin_amdgcn_mfma_f32_16x16x32_bf16(af, bfr[bj][ct][1], al[ct], 0, 0, 0); } }
                const int r128 = wr * 64 + m * 16;
#pragma unroll
                for (int ct = 0; ct < 3; ++ct) if (ct < 2 || fr < 4) *(LAS f32x4*)(slab + (wc * XB_COLS + 16 * ct + fr) * SLAB_PITCH + r128 + 4 * fq) = al[ct];
                float sq = ssq[ai][m]; sq += __shfl_xor(sq, 16); sq += __shfl_xor(sq, 32);
                if (fq == 0) slab[(wc * XB_COLS + 36) * SLAB_PITCH + r128 + fr] = sq;
            }
            __syncthreads();
            for (int idx = tid; idx < 37 * 32; idx += NTHREADS) { const int col = idx >> 5, r4 = idx & 31;
                f32x4 sv = *(const LAS f32x4*)(slab + col * SLAB_PITCH + 4 * r4);
#pragma unroll
                for (int w = 1; w < 4; ++w) sv += *(const LAS f32x4*)(slab + (w * XB_COLS + col) * SLAB_PITCH + 4 * r4);
                pg8::st16_wt(XBf + (((size_t)(u.pm * 4 + u.pn) * XB_COLS + col) * 256 + ai * 128 + 4 * r4), __builtin_bit_cast(u32x4, sv)); }
            __syncthreads();
        }
        VM_WAIT();
        if (lane == 0) (void)xb_add(&ctl[CW_PANEL + 64 * u.pm], 1u);
        if (wid == 0) { unsigned* w = &ctl[CW_PANEL + 64 * u.pm]; XB_SPIN(xb_ld(w) < 32u, ctl + CW_BAR); __builtin_amdgcn_fence(__ATOMIC_ACQUIRE, "agent"); VM_WAIT(); }
        LAS unsigned* lcnt = (LAS unsigned*)(lds + LDS_LCNT); LAS unsigned* lbase = (LAS unsigned*)(lds + LDS_LBASE);
        if (tid < NE) lcnt[tid] = 0u;
        __syncthreads();
        for (int idx = tid; idx < 37 * 16; idx += NTHREADS) { const int col = idx >> 4, r4 = idx & 15; f32x4 sv = (f32x4){0.f, 0.f, 0.f, 0.f};
#pragma unroll
            for (int sct = 0; sct < 4; ++sct) { unsigned long long* p = (unsigned long long*)(XBf + (((size_t)(u.pm * 4 + sct) * XB_COLS + col) * 256 + u.pn * 64 + 4 * r4));
                const unsigned long long a0 = __hip_atomic_load(p, __ATOMIC_RELAXED, __HIP_MEMORY_SCOPE_AGENT), a1 = __hip_atomic_load(p + 1, __ATOMIC_RELAXED, __HIP_MEMORY_SCOPE_AGENT);
                sv[0] += __uint_as_float((unsigned)a0); sv[1] += __uint_as_float((unsigned)(a0 >> 32)); sv[2] += __uint_as_float((unsigned)a1); sv[3] += __uint_as_float((unsigned)(a1 >> 32)); }
            LAS float* lgp = (LAS float*)(lds + LDS_REX + (r4 >> 2) * REX_BYTES);
#pragma unroll
            for (int j = 0; j < 4; ++j) { const int r16 = 4 * (r4 & 3) + j; if (col < 36) lgp[r16 * 36 + col] = sv[j]; else lgp[576 + r16] = sv[j]; } }
        __syncthreads();
        const int pr = wid >> 1; const bool sel = ((wid & 1) == 0) && lane < 16;
        const int rw = u.pm * 256 + u.pn * 64 + pr * 16 + lane;
        Route rt; rt.e0 = 0; rt.e1 = 0; rt.w0 = 0.f; rt.w1 = 0.f; float rstd = 0.f; unsigned q0 = 0u, q1 = 0u;
        if (sel) {
            const LAS float* l = (const LAS float*)(lds + LDS_REX + pr * REX_BYTES) + 36 * lane; rstd = rsqrtf(((const LAS float*)(lds + LDS_REX + pr * REX_BYTES))[576 + lane] * (1.f / D) + EPS);
            int gi = 0; float gmax = l[0] * rstd + bgp[0];
            for (int c = 1; c < 4; ++c) { const float v = l[c] * rstd + bgp[c]; if (v > gmax) { gmax = v; gi = c; } }
            float den = 0.f; for (int c = 0; c < 4; ++c) den += __expf(l[c] * rstd + bgp[c] - gmax);
            const float gprob = 1.f / den;
            float b0 = -INFINITY, b1 = -INFINITY; int i0 = 0, i1 = 0;
            for (int c = 0; c < 8; ++c) { const float v = l[4 + gi * 8 + c] * rstd + be[gi * 8 + c]; if (v > b0) { b1 = b0; i1 = i0; b0 = v; i0 = c; } else if (v > b1) { b1 = v; i1 = c; } }
            const float e1x = __expf(b1 - b0);
            rt.e0 = gi * 8 + i0; rt.e1 = gi * 8 + i1; rt.w0 = gprob / (1.f + e1x); rt.w1 = gprob * e1x / (1.f + e1x);
            q0 = __hip_atomic_fetch_add(lcnt + rt.e0, 1u, __ATOMIC_RELAXED, __HIP_MEMORY_SCOPE_WORKGROUP); q1 = __hip_atomic_fetch_add(lcnt + rt.e1, 1u, __ATOMIC_RELAXED, __HIP_MEMORY_SCOPE_WORKGROUP);
        }
        __syncthreads();
        if (tid < NE) lbase[tid] = atomicAdd((unsigned*)(ws + WS_CTL) + CW_CNT + tid * CNT_STRIDE, lcnt[tid]);
        __syncthreads();
        if (sel) { int* LIST = (int*)(ws + WS_LIST);
            { const int idx = rt.e0 * LIST_CAP + (int)(lbase[rt.e0] + q0); LIST[idx] = rw * 2; ((float*)(ws + WS_LRS))[idx] = rstd; ((float*)(ws + WS_LGW))[idx] = rt.w0; }
            { const int idx = rt.e1 * LIST_CAP + (int)(lbase[rt.e1] + q1); LIST[idx] = rw * 2 + 1; ((float*)(ws + WS_LRS))[idx] = rstd; ((float*)(ws + WS_LGW))[idx] = rt.w1; } }
    }
};
namespace pg8 {
struct MoeOrder {
    const LAS int* pb; const LAS int* pba; const LAS int* cn; const int* list; const char* A; const char* W; int K, nN, G, c, gather; size_t wstride;
    __device__ __forceinline__ bool next(int i, Unit& u) const {
        const int L = i * G + c, NB = pb[NE]; if (L >= NB * nN) return false;
        const int rb = L / nN; u.pn = L % nN;
        int e = 0;
#pragma unroll
        for (int s = 16; s >= 1; s >>= 1) if (pb[e + s] <= rb) e += s;
        u.e = e; u.pm = rb - pb[e]; const int left = cn[e] - 256 * u.pm; u.nrows = left < 256 ? left : 256; return true;
    }
    __device__ __forceinline__ void a_off(const Unit& u, const int (&R)[2], const int (&C)[2], unsigned (&off)[2][2]) const {
#pragma unroll
        for (int h = 0; h < 2; ++h)
#pragma unroll
            for (int i = 0; i < 2; ++i) { const int r = h * HALF + R[i];
                if (gather) { const int tok = r < u.nrows ? (list[u.e * LIST_CAP + 256 * u.pm + r] >> 1) : 0; off[h][i] = (unsigned)((tok * K + C[i]) * 2); }
                else off[h][i] = (unsigned)(((256 * (pba[u.e] + u.pm) + r) * K + C[i]) * 2); }
    }
    __device__ __forceinline__ const char* a_base() const { return A; }
    __device__ __forceinline__ const char* b_base(const Unit& u) const { return W + (size_t)u.e * wstride + (size_t)u.pn * BM * K * 2; }
};
struct EpiMoeUp {
    static constexpr bool PERM = true, AFTER_DRAIN = false;
    bf16* HID; const float* lrs; const float* lgw; const LAS int* pba;
    __device__ __forceinline__ void operator()(const f32x4 (&acc)[2][2][4][2], const Unit& u, int wr, int wc, int fr, int fq) const {
        const int prow0 = 256 * (pba[u.e] + u.pm);
        float rsv[2][4], gwv[2][4];
#pragma unroll
        for (int ai = 0; ai < 2; ++ai)
#pragma unroll
            for (int m = 0; m < 4; ++m) { const int r = ai * HALF + wr * 64 + m * 16 + fr; const int li = u.e * LIST_CAP + 256 * u.pm + (r < u.nrows ? r : 0); rsv[ai][m] = lrs[li]; gwv[ai][m] = lgw[li]; }
#pragma unroll
        for (int ai = 0; ai < 2; ++ai)
#pragma unroll
            for (int m = 0; m < 4; ++m) { const int r = ai * HALF + wr * 64 + m * 16 + fr;
                const float rs = rsv[ai][m], gw = gwv[ai][m];
                float hv[8];
#pragma unroll
                for (int n = 0; n < 2; ++n)
#pragma unroll
                    for (int q = 0; q < 4; ++q) { const float x = acc[ai][0][m][n][q] * rs, y = acc[ai][1][m][n][q] * rs; hv[4 * n + q] = x * __builtin_amdgcn_rcpf(1.f + __expf(-x)) * (y * gw); }
                u32x4 w; w.x = cvt_pk_bf16(hv[0], hv[1]); w.y = cvt_pk_bf16(hv[2], hv[3]); w.z = cvt_pk_bf16(hv[4], hv[5]); w.w = cvt_pk_bf16(hv[6], hv[7]);
                *(u32x4*)(HID + (size_t)(prow0 + r) * FF + 128 * u.pn + 32 * wc + 8 * fq) = w; }
    }
};
struct EpiMoeDown {
    static constexpr bool PERM = true, AFTER_DRAIN = false;
    bf16* Y; const int* list;
    __device__ __forceinline__ void operator()(const f32x4 (&acc)[2][2][4][2], const Unit& u, int wr, int wc, int fr, int fq) const {
        int slotv[2][4];
#pragma unroll
        for (int ai = 0; ai < 2; ++ai)
#pragma unroll
            for (int m = 0; m < 4; ++m) { const int r = ai * HALF + wr * 64 + m * 16 + fr; slotv[ai][m] = list[u.e * LIST_CAP + 256 * u.pm + (r < u.nrows ? r : 0)]; }
#pragma unroll
        for (int ai = 0; ai < 2; ++ai)
#pragma unroll
            for (int m = 0; m < 4; ++m) { const int r = ai * HALF + wr * 64 + m * 16 + fr;
                if (r < u.nrows) { const int slot = slotv[ai][m];
                    bf16* rowp = Y + (size_t)slot * D + u.pn * BM + wc * 32 + 8 * fq;
#pragma unroll
                    for (int bj = 0; bj < 2; ++bj) { const f32x4 v0 = acc[ai][bj][m][0], v1 = acc[ai][bj][m][1];
                        u32x4 o; o.x = cvt_pk_bf16(v0[0], v0[1]); o.y = cvt_pk_bf16(v0[2], v0[3]); o.z = cvt_pk_bf16(v1[0], v1[1]); o.w = cvt_pk_bf16(v1[2], v1[3]);
                        pg8::st16_wt(rowp + bj * HALF, o); } } }
    }
};
}
constexpr int LDS_PBA = LDSCTL_OFF + 512, LDS_PTR = LDSCTL_OFF + 656;
__device__ __forceinline__ void moe_prefix(const Args& a, LAS unsigned char* lds, int G) {
    const unsigned* cnt = (const unsigned*)(a.ws + WS_CTL) + CW_CNT;
    LAS int* pb = (LAS int*)(lds + LDS_PB); LAS int* cn = (LAS int*)(lds + LDS_CNT); LAS int* pba = (LAS int*)(lds + LDS_PBA); LAS int* ptr = (LAS int*)(lds + LDS_PTR);
    __syncthreads();
    if (threadIdx.x < 64) {
        const int lane = threadIdx.x, e = lane & 31; const int c = (int)cnt[e * CNT_STRIDE];
        const int nf = c >> 8, tail = c & 255;
        int nbf = nf;
#pragma unroll
        for (int o = 1; o < 32; o <<= 1) nbf += __shfl_xor(nbf, o);
        const int cap = ((4 * nbf + G - 1) / G) * G / 4, x = cap - nbf;
        int rank = 0;
#pragma unroll 1
        for (int j = 0; j < 32; ++j) { const int tj = __shfl(tail, j); rank += (tj > tail || (tj == tail && j < e)) ? 1 : 0; }
        const int istile = (tail > 0 && rank < x) ? 1 : 0;
        const int nbt = nf + istile, nba = (c + 255) >> 8, ntr = (!istile && tail > 0) ? ((tail + 31) >> 5) : 0;
        int s1 = nbt, s2 = nba, s3 = ntr;
#pragma unroll
        for (int o = 1; o < 32; o <<= 1) { const int t1 = __shfl_up(s1, o), t2 = __shfl_up(s2, o), t3 = __shfl_up(s3, o); if (e >= o) { s1 += t1; s2 += t2; s3 += t3; } }
        if (lane < 32) { cn[e] = c; pb[e + 1] = s1; pba[e + 1] = s2; ptr[e + 1] = s3; if (e == 0) { pb[0] = 0; pba[0] = 0; ptr[0] = 0; } }
    }
    __syncthreads();
}
template <int NJ> __device__ __forceinline__ void wave_mm_tail(const bf16* a0, const bf16* a1, const bf16* b0, size_t bstride16, int K, f32x4 (&acc)[2][NJ]) {
    const int fq = (threadIdx.x & 63) >> 4;
#pragma unroll 2
    for (int k0 = 0; k0 < K; k0 += 32) {
        const bf16x8 fa0 = *(const bf16x8*)(a0 + k0 + 8 * fq), fa1 = *(const bf16x8*)(a1 + k0 + 8 * fq);
#pragma unroll
        for (int j = 0; j < NJ; ++j) { const bf16x8 fb = *(const bf16x8*)(b0 + j * bstride16 + k0 + 8 * fq);
            acc[0][j] = __builtin_amdgcn_mfma_f32_16x16x32_bf16(fa0, fb, acc[0][j], 0, 0, 0); acc[1][j] = __builtin_amdgcn_mfma_f32_16x16x32_bf16(fa1, fb, acc[1][j], 0, 0, 0); }
    }
}
template <bool UP> __device__ __forceinline__ void moe_tail_tasks(const Args& a, LAS unsigned char* lds, int c_, int G) {
    const LAS int* pb = (const LAS int*)(lds + LDS_PB); const LAS int* cn = (const LAS int*)(lds + LDS_CNT); const LAS int* pba = (const LAS int*)(lds + LDS_PBA); const LAS int* ptr = (const LAS int*)(lds + LDS_PTR);
    const int tid = threadIdx.x, lane = tid & 63, wave = __builtin_amdgcn_readfirstlane(tid >> 6), fr = lane & 15;
    constexpr int NJ = UP ? 4 : 8, CW = 16 * NJ, NCT = (UP ? FF : D) / CW, K = UP ? D : FF, KW = K / NWAVES, NTILE = (UP ? 2 : 1) * 2 * NJ;
    const int NT = ptr[NE] * NCT;
    const int* list = (const int*)(a.ws + WS_LIST); const bf16* N2 = (const bf16*)(a.ws + WS_N2); bf16* HID = (bf16*)(a.ws + WS_HID);
    LAS f32x4* P = (LAS f32x4*)lds;
#pragma unroll 1
    for (int tt = c_; tt < NT; tt += G) {
        const int rt = tt / NCT, ct = tt % NCT;
        int e = 0;
#pragma unroll
        for (int s = 16; s >= 1; s >>= 1) if (ptr[e + s] <= rt) e += s;
        const int c = cn[e], r0 = 256 * (pb[e + 1] - pb[e]) + 32 * (rt - ptr[e]), prow = 256 * pba[e];
        const int p0 = r0 + fr, p1 = r0 + 16 + fr, k0 = wave * KW;
        if (UP) {
            const int t0 = p0 < c ? (list[e * LIST_CAP + p0] >> 1) : 0, t1 = p1 < c ? (list[e * LIST_CAP + p1] >> 1) : 0;
            const int j0 = ct * CW + fr, ra = 256 * (j0 >> 7) + (j0 & 127);
            const bf16* W = (const bf16*)(a.ws + WS_W13) + (size_t)e * D * D + k0;
            f32x4 accA[2][NJ] = {}, accB[2][NJ] = {};
            wave_mm_tail<NJ>(N2 + (size_t)t0 * D + k0, N2 + (size_t)t1 * D + k0, W + (size_t)ra * D, (size_t)16 * D, KW, accA);
            wave_mm_tail<NJ>(N2 + (size_t)t0 * D + k0, N2 + (size_t)t1 * D + k0, W + (size_t)(ra + 128) * D, (size_t)16 * D, KW, accB);
#pragma unroll
            for (int i = 0; i < 2; ++i)
#pragma unroll
                for (int j = 0; j < NJ; ++j) { P[(wave * NTILE + i * NJ + j) * 64 + lane] = accA[i][j]; P[(wave * NTILE + 2 * NJ + i * NJ + j) * 64 + lane] = accB[i][j]; }
        } else {
            const int q0 = p0 < c ? p0 : 0, q1 = p1 < c ? p1 : 0, c0 = ct * CW;
            const bf16* W = (const bf16*)(a.ws + WS_W2) + (size_t)e * D * FF + k0;
            f32x4 acc[2][NJ] = {};
            wave_mm_tail<NJ>(HID + (size_t)(prow + q0) * FF + k0, HID + (size_t)(prow + q1) * FF + k0, W + (size_t)(c0 + fr) * FF, (size_t)16 * FF, KW, acc);
#pragma unroll
            for (int i = 0; i < 2; ++i)
#pragma unroll
                for (int j = 0; j < NJ; ++j) P[(wave * NTILE + i * NJ + j) * 64 + lane] = acc[i][j];
        }
        __syncthreads();
        {
            const int ln = tid & 63, g = tid >> 6, frr = ln & 15, fqq = ln >> 4;
#pragma unroll
            for (int q = 0; q < (UP ? 1 : 2); ++q) { const int ij = UP ? g : 2 * g + q, i = ij / NJ, j = ij % NJ;
                f32x4 sa = (f32x4){0.f, 0.f, 0.f, 0.f}, sb = sa;
#pragma unroll
                for (int w = 0; w < NWAVES; ++w) { sa += P[(w * NTILE + ij) * 64 + ln]; if (UP) sb += P[(w * NTILE + 2 * NJ + ij) * 64 + ln]; }
#pragma unroll
                for (int r = 0; r < 4; ++r) { const int pos = r0 + 16 * i + 4 * fqq + r;
                    if (pos < c) {
                        const int slot = list[e * LIST_CAP + pos];
                        if (UP) { const float rs = ((const float*)(a.ws + WS_LRS))[e * LIST_CAP + pos], w = ((const float*)(a.ws + WS_LGW))[e * LIST_CAP + pos]; const float x = sa[r] * rs, y = sb[r] * rs;
                            HID[(size_t)(prow + pos) * FF + ct * CW + 16 * j + frr] = f2bf(x * __builtin_amdgcn_rcpf(1.f + __expf(-x)) * (y * w)); }
                        else ((bf16*)(a.ws + WS_Y))[(size_t)slot * D + ct * CW + 16 * j + frr] = f2bf(sa[r]); } } }
        }
        __syncthreads();
    }
}
typedef short v4i16_t __attribute__((ext_vector_type(4)));
typedef float f32x16 __attribute__((ext_vector_type(16)));
template <int RB> __device__ __forceinline__ int img_off(int row, int chunk) { return row * RB + ((chunk ^ (row & 7)) << 4); }
template <int RB> __device__ __forceinline__ bf16x8 frag_row(const LAS unsigned char* img, int row0, int k0, int lane) {
    return *(const LAS bf16x8*)(img + img_off<RB>(row0 + (lane & 31), (k0 >> 3) + (lane >> 5)));
}
template <int RB, bool PERMK> __device__ __forceinline__ bf16x8 frag_col(const LAS unsigned char* img, int k0, int n0, int lane) {
    const int h = lane >> 5, ch = (lane >> 4) & 1, q = (lane & 15) >> 2, p = lane & 3;
    const int ra = k0 + (PERMK ? 4 * h : 8 * h) + q, rb = ra + (PERMK ? 8 : 4);
    const int chunk = (n0 >> 3) + 2 * ch + (p >> 1), sub = (p & 1) * 8;
    const v4i16_t lo = __builtin_amdgcn_ds_read_tr16_b64_v4i16((LAS v4i16_t*)(img + img_off<RB>(ra, chunk) + sub));
    const v4i16_t hi = __builtin_amdgcn_ds_read_tr16_b64_v4i16((LAS v4i16_t*)(img + img_off<RB>(rb, chunk) + sub));
    return (bf16x8){lo[0], lo[1], lo[2], lo[3], hi[0], hi[1], hi[2], hi[3]};
}
__device__ __forceinline__ int crow(int r, int h) { return (r & 3) + 8 * (r >> 2) + 4 * h; }
__device__ __forceinline__ bf16x8 pack8(const f32x16& x, int s) {
    u32x4 w; w.x = pg8::cvt_pk_bf16(x[8 * s], x[8 * s + 1]); w.y = pg8::cvt_pk_bf16(x[8 * s + 2], x[8 * s + 3]); w.z = pg8::cvt_pk_bf16(x[8 * s + 4], x[8 * s + 5]); w.w = pg8::cvt_pk_bf16(x[8 * s + 6], x[8 * s + 7]);
    return __builtin_bit_cast(bf16x8, w);
}

constexpr int ATT_UNITS = BATCH * 8 * 3 * 32;
constexpr int ATT_LK = 0, ATT_LV = 49152, ATT_STG = 98304, ATT_WS = 131072;
constexpr float ATT_C = 0.125f * 1.4426950408889634f;
struct AttU { int b, head, br, d, r, i0; };
__device__ __forceinline__ AttU attn_decode(int u) { AttU a; const int x = u & 31; a.br = (u >> 5) % 3; const int bh = (u >> 5) / 3; a.b = bh >> 3; a.head = bh & 7;
    a.d = a.br == 0 ? 1 : (a.br == 1 ? 4 : 16); const int nblk = 32 / a.d; a.r = x / nblk; a.i0 = (x % nblk) * 256; return a; }
template <int WHICH> __device__ __forceinline__ void attn_fetch(const AttU& a, const bf16* proj, u32x4 (&kv)[6]) {
    const int tid = threadIdx.x; const bf16* pb = proj + (size_t)a.b * T * NPROJ + a.head * 64 + (WHICH ? C_AV : C_AK);
#pragma unroll
    for (int it = 0; it < 6; ++it) { const int c = tid + NTHREADS * it, row = c >> 3, ch = c & 7, ki = a.i0 - 128 + row, kc = ki < 0 ? 0 : ki;
        kv[it] = *(const u32x4*)(pb + (size_t)(kc * a.d + a.r) * NPROJ + ch * 8); }
}
template <int WHICH> __device__ __forceinline__ void attn_put(const u32x4 (&kv)[6], LAS unsigned char* lds) {
    const int tid = threadIdx.x;
#pragma unroll
    for (int it = 0; it < 6; ++it) { const int c = tid + NTHREADS * it, row = c >> 3, ch = c & 7; *(LAS u32x4*)(lds + (WHICH ? ATT_LV : ATT_LK) + img_off<128>(row, ch)) = kv[it]; }
}
__device__ __forceinline__ void attn_unit(const AttU& a, const AttU& an, u32x4 (&kk)[6], u32x4 (&vv)[6], const bf16* proj, bf16* OBR, float* ML, LAS unsigned char* lds) {
    const int tid = threadIdx.x, lane = tid & 63, w = __builtin_amdgcn_readfirstlane(tid >> 6), r32 = lane & 31, h = lane >> 5;
    const int d = a.d, r = a.r, i0 = a.i0, b = a.b, head = a.head, br = a.br;
    const bf16* pb = proj + (size_t)b * T * NPROJ + head * 64;
    bf16x8 qf[4];
    { const bf16* qp = pb + (size_t)((i0 + 32 * w + r32) * d + r) * NPROJ + C_AQ + 8 * h;
#pragma unroll
      for (int s = 0; s < 4; ++s) qf[s] = *(const bf16x8*)(qp + 16 * s); }
    attn_put<0>(kk, lds); attn_put<1>(vv, lds);
    __syncthreads();
    attn_fetch<0>(an, proj, kk);
    f32x16 S[5];
    { bf16x8 kf[2][4];
#pragma unroll
      for (int s = 0; s < 4; ++s) kf[0][s] = frag_row<128>(lds + ATT_LK, 32 * w, 16 * s, lane);
#pragma unroll
      for (int t = 0; t < 5; ++t) {
          if (t < 4) {
#pragma unroll
              for (int s = 0; s < 4; ++s) kf[(t + 1) & 1][s] = frag_row<128>(lds + ATT_LK, 32 * w + 32 * (t + 1), 16 * s, lane); }
          __builtin_amdgcn_sched_barrier(0);
          S[t] = (f32x16){};
#pragma unroll
          for (int s = 0; s < 4; ++s) S[t] = __builtin_amdgcn_mfma_f32_32x32x16_bf16(kf[t & 1][s], qf[s], S[t], 0, 0, 0);
          __builtin_amdgcn_sched_barrier(0); } }
    const int kbase = i0 + 32 * w - 128;
#pragma unroll
    for (int rr = 0; rr < 16; ++rr) { const int kr = crow(rr, h); S[0][rr] = (kr >= r32) ? S[0][rr] : -INFINITY; S[4][rr] = (kr <= r32) ? S[4][rr] : -INFINITY; }
    if (kbase < 0) {
#pragma unroll
        for (int t = 0; t < 5; ++t)
#pragma unroll
            for (int rr = 0; rr < 16; ++rr) S[t][rr] = (kbase + 32 * t + crow(rr, h)) >= 0 ? S[t][rr] : -INFINITY; }
    float mx = -INFINITY;
#pragma unroll
    for (int t = 0; t < 5; ++t)
#pragma unroll
        for (int rr = 0; rr < 16; ++rr) mx = fmaxf(mx, S[t][rr]);
    mx = fmaxf(mx, __shfl_xor(mx, 32)) * ATT_C;
    float ls = 0.f;
    f32x16 O[2]; O[0] = (f32x16){}; O[1] = (f32x16){};
    { bf16x8 vf[2][2];
#pragma unroll
      for (int db = 0; db < 2; ++db) vf[0][db] = frag_col<128, true>(lds + ATT_LV, 32 * w, 32 * db, lane);
#pragma unroll
      for (int t = 0; t < 5; ++t) {
#pragma unroll
          for (int rr = 0; rr < 16; ++rr) { const float pv = __builtin_amdgcn_exp2f(__builtin_fmaf(S[t][rr], ATT_C, -mx)); S[t][rr] = pv; ls += pv; }
          bf16x8 pa[2]; pa[0] = pack8(S[t], 0); pa[1] = pack8(S[t], 1);
          if (t == 2) {
              __builtin_amdgcn_sched_barrier(0);
              attn_fetch<1>(an, proj, vv); }
          __builtin_amdgcn_sched_barrier(0);
#pragma unroll
          for (int s2 = 0; s2 < 2; ++s2) { const int i = 2 * t + s2;
              if (i < 9) {
#pragma unroll
                  for (int db = 0; db < 2; ++db) vf[(i + 1) & 1][db] = frag_col<128, true>(lds + ATT_LV, 32 * w + 16 * (i + 1), 32 * db, lane); }
              __builtin_amdgcn_sched_barrier(0);
#pragma unroll
              for (int db = 0; db < 2; ++db) O[db] = __builtin_amdgcn_mfma_f32_32x32x16_bf16(vf[i & 1][db], pa[s2], O[db], 0, 0, 0);
              __builtin_amdgcn_sched_barrier(0); } } }
    ls += __shfl_xor(ls, 32);
    { const float il = 1.f / ls;
      bf16* orow = OBR + ((size_t)br * M + (size_t)b * T + (size_t)((i0 + 32 * w + r32) * d + r)) * 512 + head * 64 + 8 * h;
#pragma unroll
      for (int db = 0; db < 2; ++db)
#pragma unroll
          for (int gp = 0; gp < 2; ++gp) {
              unsigned ax = pg8::cvt_pk_bf16(O[db][8 * gp] * il, O[db][8 * gp + 1] * il), ay = pg8::cvt_pk_bf16(O[db][8 * gp + 2] * il, O[db][8 * gp + 3] * il);
              unsigned bx2 = pg8::cvt_pk_bf16(O[db][8 * gp + 4] * il, O[db][8 * gp + 5] * il), by = pg8::cvt_pk_bf16(O[db][8 * gp + 6] * il, O[db][8 * gp + 7] * il);
              { const auto sx = __builtin_amdgcn_permlane32_swap(ax, bx2, false, false); ax = sx[0]; bx2 = sx[1]; }
              { const auto sy = __builtin_amdgcn_permlane32_swap(ay, by, false, false); ay = sy[0]; by = sy[1]; }
              *(u32x4*)(orow + 32 * db + 16 * gp) = (u32x4){ax, ay, bx2, by}; } }
    if (h == 0) { float* ml = ML + (((size_t)br * M + (size_t)b * T + (size_t)((i0 + 32 * w + r32) * d + r)) * 8 + head) * 2; ml[0] = mx; ml[1] = ls; }
    __syncthreads();
}
constexpr int ATT_SPLIT = ATT_UNITS / 2;
__device__ __forceinline__ void attn_units(int first, int stride, int end, const bf16* proj, bf16* OBR, float* ML, LAS unsigned char* lds) {
    if (first >= end) return;
    u32x4 kv[6], vv[6]; AttU cur = attn_decode(first); attn_fetch<0>(cur, proj, kv); attn_fetch<1>(cur, proj, vv);
#pragma unroll 1
    for (int u = first; u < end; u += stride) {
        const bool hn = u + stride < end; const AttU nxt = attn_decode(hn ? u + stride : u);
        attn_unit(cur, nxt, kv, vv, proj, OBR, ML, lds);
        cur = nxt;
    }
}
__device__ __forceinline__ void attn_merge_rows(const bf16* OBR, const float* ML, bf16* O, int gw, int NGW, int lane) {
    constexpr int MB = 4;
    const int head = lane >> 3;
#pragma unroll 1
    for (int m0 = gw; m0 < M; m0 += NGW * MB) {
        float mm[MB][3], ll[MB][3]; u32x4 ov[MB][3];
#pragma unroll
        for (int b = 0; b < MB; ++b) { const int m = min(m0 + b * NGW, M - 1);
#pragma unroll
            for (int br = 0; br < 3; ++br) { const float2 ml = *(const float2*)(ML + (((size_t)br * M + m) * 8 + head) * 2); mm[b][br] = ml.x; ll[b][br] = ml.y;
                ov[b][br] = __builtin_nontemporal_load((const u32x4*)(OBR + ((size_t)br * M + m) * 512 + lane * 8)); } }
#pragma unroll
        for (int b = 0; b < MB; ++b) { const int m = m0 + b * NGW;
            const float mxx = fmaxf(fmaxf(mm[b][0], mm[b][1]), mm[b][2]);
            float wgt[3], wsum = 0.f;
#pragma unroll
            for (int br = 0; br < 3; ++br) { wgt[br] = ll[b][br] * __builtin_amdgcn_exp2f(mm[b][br] - mxx); wsum += wgt[br]; }
            const float iw = 1.f / wsum; float acc[8];
#pragma unroll
            for (int e = 0; e < 8; ++e) acc[e] = 0.f;
#pragma unroll
            for (int br = 0; br < 3; ++br) { const float wb = wgt[br] * iw;
#pragma unroll
                for (int e = 0; e < 4; ++e) { const unsigned pk = ov[b][br][e]; acc[2 * e] += wb * __uint_as_float(pk << 16); acc[2 * e + 1] += wb * __uint_as_float(pk & 0xffff0000u); } }
            u32x4 o; o.x = pk2(acc[0], acc[1]); o.y = pk2(acc[2], acc[3]); o.z = pk2(acc[4], acc[5]); o.w = pk2(acc[6], acc[7]);
            if (m < M) *(u32x4*)(O + (size_t)m * D + 512 + lane * 8) = o;
        }
    }
}
constexpr int GLA_SEG = 256, GLA_NSEG = T / GLA_SEG, GLA_UNITS = BATCH * 4 * GLA_NSEG;
constexpr int GL_QP = 16384, GL_KP = 24576, GL_KPP = 32768, GL_V = 40960, GL_ST = 57344, GL_O = 73728, GL_PART = 107520, GL_GLR = 109568, GL_AL = 113664;
constexpr int GL_OLD = 132;
constexpr size_t WS_GLAS_A = WS_GLAS + 8 * MiB;
struct GLoad { f32x4 glr; u32x4 v[2]; bf16 k[8], q[8]; };
__device__ __forceinline__ float fast_logsigmoid(float z) {
    const float e = __builtin_amdgcn_exp2f(-fabsf(z) * 1.4426950408889634f);
    return fminf(z, 0.f) - __builtin_amdgcn_logf(1.f + e) * 0.6931471805599453f;
}
template <bool FULL> __device__ __forceinline__ void gla_fetch(GLoad& L, const bf16* proj, const float* glr, int b, int h, int t0) {
    const int tid = threadIdx.x, dk = tid & 63, tg = tid >> 6; const size_t row0 = (size_t)b * T + t0;
    L.glr = (f32x4){0.f, 0.f, 0.f, 0.f}; if (tid < 256) L.glr = ((const f32x4*)(glr + row0 * 16))[tid];
#pragma unroll
    for (int j = 0; j < 2; ++j) { const int c = tid + NTHREADS * j, tok = c >> 4, ch = c & 15; L.v[j] = *(const u32x4*)(proj + (row0 + tok) * NPROJ + C_GV + h * 128 + ch * 8); }
#pragma unroll
    for (int i = 0; i < 8; ++i) { const bf16* pr = proj + (row0 + tg * 8 + i) * NPROJ + h * 64 + dk; L.k[i] = pr[C_GK]; if (FULL) L.q[i] = pr[C_GQ]; }
}
template <bool FULL> __device__ __forceinline__ float gla_prep(const GLoad& L, const float (&w2r)[16], float bb, LAS unsigned char* lds) {
    const int tid = threadIdx.x, dk = tid & 63, tg = tid >> 6;
    LAS float* gl = (LAS float*)(lds + GL_GLR); LAS float* part = (LAS float*)(lds + GL_PART); LAS float* al = (LAS float*)(lds + GL_AL);
    if (tid < 256) *(LAS f32x4*)(gl + 4 * tid) = L.glr;
#pragma unroll
    for (int j = 0; j < 2; ++j) { const int c = tid + NTHREADS * j, tok = c >> 4, ch = c & 15; *(LAS u32x4*)(lds + GL_V + img_off<256>(tok, ch)) = L.v[j]; }
    __syncthreads();
    float la[8];
#pragma unroll
    for (int i = 0; i < 8; ++i) { const LAS float* g = gl + (tg * 8 + i) * 16; float z = bb;
#pragma unroll
        for (int q = 0; q < 4; ++q) { const f32x4 gv = *(const LAS f32x4*)(g + 4 * q); z += gv.x * w2r[4 * q] + gv.y * w2r[4 * q + 1] + gv.z * w2r[4 * q + 2] + gv.w * w2r[4 * q + 3]; }
        la[i] = fast_logsigmoid(z) * (1.f / 16.f); }
#pragma unroll
    for (int i = 1; i < 8; ++i) la[i] += la[i - 1];
    part[tg * 64 + dk] = la[7];
    __syncthreads();
    float offs = 0.f, glast = 0.f;
#pragma unroll
    for (int g = 0; g < 8; ++g) { const float pv = part[g * 64 + dk]; glast += pv; if (g < tg) offs += pv; }
    if (tg == 0) al[dk] = __expf(glast);
#pragma unroll
    for (int i = 0; i < 8; ++i) { const int tok = tg * 8 + i; const float G = offs + la[i];
        const float kv = bf2f(L.k[i]); const int o = img_off<128>(tok, dk >> 3) + (dk & 7) * 2;
        *(LAS bf16*)(lds + GL_KPP + o) = (bf16)pg8::cvt_pk_bf16(kv * __expf(glast - G), 0.f);
        if (FULL) { const float qv = bf2f(L.q[i]) * 0.125f; *(LAS bf16*)(lds + GL_QP + o) = (bf16)pg8::cvt_pk_bf16(qv * __expf(G), 0.f); *(LAS bf16*)(lds + GL_KP + o) = (bf16)pg8::cvt_pk_bf16(kv * __expf(-G), 0.f); } }
    return glast;
}
__device__ __forceinline__ void gla_state_update(f32x16& Sacc, LAS unsigned char* lds, int rb, int cb, int lane) {
    f32x16 U = (f32x16){};
#pragma unroll
    for (int s = 0; s < 4; ++s) U = __builtin_amdgcn_mfma_f32_32x32x16_bf16(frag_col<128, false>(lds + GL_KPP, 16 * s, 32 * rb, lane), frag_col<256, false>(lds + GL_V, 16 * s, 32 * cb, lane), U, 0, 0, 0);
    const LAS float* al = (const LAS float*)(lds + GL_AL);
#pragma unroll
    for (int r = 0; r < 16; ++r) Sacc[r] = al[32 * rb + crow(r, lane >> 5)] * Sacc[r] + U[r];
}
__device__ __forceinline__ void gla_pass1_unit(int u, const Args& a, LAS unsigned char* lds) {
    const int tid = threadIdx.x, lane = tid & 63, w = __builtin_amdgcn_readfirstlane(tid >> 6), rb = w >> 2, cb = w & 3;
    const int seg = u % GLA_NSEG, bh = u / GLA_NSEG, b = bh >> 2, h = bh & 3, dk = tid & 63;
    const bf16* proj = (const bf16*)(a.ws + WS_PROJ); const float* glr = (const float*)(a.ws + WS_GLR);
    float w2r[16];
#pragma unroll
    for (int r = 0; r < 16; ++r) w2r[r] = a.in[3][r * 256 + h * 64 + dk];
    const float bb = a.in[4][h * 64 + dk];
    f32x16 Sacc = (f32x16){}; float gsum = 0.f;
    GLoad L; gla_fetch<false>(L, proj, glr, b, h, seg * GLA_SEG);
#pragma unroll 1
    for (int c = 0; c < GLA_SEG / 64; ++c) {
        gsum += gla_prep<false>(L, w2r, bb, lds);
        if (c + 1 < GLA_SEG / 64) gla_fetch<false>(L, proj, glr, b, h, seg * GLA_SEG + (c + 1) * 64);
        __syncthreads();
        gla_state_update(Sacc, lds, rb, cb, lane);
        __syncthreads();
    }
    float* U = (float*)(a.ws + WS_GLAS) + (size_t)u * 64 * 128;
#pragma unroll
    for (int r = 0; r < 16; ++r) U[(32 * rb + crow(r, lane >> 5)) * 128 + 32 * cb + (lane & 31)] = Sacc[r];
    if (tid < 64) ((float*)(a.ws + WS_GLAS_A))[(size_t)u * 64 + dk] = __expf(gsum);
}
struct MrgRow { float2 ml[3]; u32x4 ov[3]; };
__device__ __forceinline__ void mrg_fetch(MrgRow& r, const Args& a, int m, int lane) {
    const bf16* OBR = (const bf16*)a.out; const float* ML = (const float*)((const unsigned char*)a.out + 48 * MiB); m = min(m, M - 1);
#pragma unroll
    for (int br = 0; br < 3; ++br) { r.ml[br] = *(const float2*)(ML + (((size_t)br * M + m) * 8 + (lane >> 3)) * 2); r.ov[br] = __builtin_nontemporal_load((const u32x4*)(OBR + ((size_t)br * M + m) * 512 + lane * 8)); }
}
__device__ __forceinline__ void mrg_finish(const MrgRow& r, const Args& a, int m, int lane) {
    const float mxx = fmaxf(fmaxf(r.ml[0].x, r.ml[1].x), r.ml[2].x);
    float wgt[3], wsum = 0.f;
#pragma unroll
    for (int br = 0; br < 3; ++br) { wgt[br] = r.ml[br].y * __builtin_amdgcn_exp2f(r.ml[br].x - mxx); wsum += wgt[br]; }
    const float iw = 1.f / wsum; float acc[8];
#pragma unroll
    for (int e = 0; e < 8; ++e) acc[e] = 0.f;
#pragma unroll
    for (int br = 0; br < 3; ++br) { const float wb = wgt[br] * iw;
#pragma unroll
        for (int e = 0; e < 4; ++e) { const unsigned pk = r.ov[br][e]; acc[2 * e] += wb * __uint_as_float(pk << 16); acc[2 * e + 1] += wb * __uint_as_float(pk & 0xffff0000u); } }
    u32x4 o; o.x = pk2(acc[0], acc[1]); o.y = pk2(acc[2], acc[3]); o.z = pk2(acc[4], acc[5]); o.w = pk2(acc[6], acc[7]);
    if (m < M) *(u32x4*)((bf16*)(a.ws + WS_O) + (size_t)m * D + 512 + lane * 8) = o;
}
template <bool FUSE_MERGE>
__device__ __forceinline__ void gla_pass2_unit(int u, const Args& a, LAS unsigned char* lds, int mrow0 = 0, int mstride = 0) {
    const int tid = threadIdx.x, lane = tid & 63, w = __builtin_amdgcn_readfirstlane(tid >> 6), rb = w >> 2, cb = w & 3, r32 = lane & 31, hh = lane >> 5;
    const int seg = u % GLA_NSEG, bh = u / GLA_NSEG, b = bh >> 2, h = bh & 3, dk = tid & 63;
    const bf16* proj = (const bf16*)(a.ws + WS_PROJ); const float* glr = (const float*)(a.ws + WS_GLR); bf16* Oo = (bf16*)(a.ws + WS_O);
    float w2r[16];
#pragma unroll
    for (int r = 0; r < 16; ++r) w2r[r] = a.in[3][r * 256 + h * 64 + dk];
    const float bb = a.in[4][h * 64 + dk];
    const int etok = tid >> 3, epart = tid & 7;
    float gn[16];
#pragma unroll
    for (int i = 0; i < 16; ++i) gn[i] = a.in[5][epart * 16 + i];
    f32x16 Sacc;
    { const float* Us = (const float*)(a.ws + WS_GLAS) + (size_t)u * 64 * 128;
#pragma unroll
      for (int r = 0; r < 16; ++r) Sacc[r] = Us[(32 * rb + crow(r, hh)) * 128 + 32 * cb + r32]; }
    GLoad L; gla_fetch<true>(L, proj, glr, b, h, seg * GLA_SEG);
#pragma unroll 1
    for (int c = 0; c < GLA_SEG / 64; ++c) {
        const int t0 = seg * GLA_SEG + c * 64;
#pragma unroll
        for (int g4 = 0; g4 < 4; ++g4) { u32x2 pk; pk.x = pg8::cvt_pk_bf16(Sacc[4 * g4], Sacc[4 * g4 + 1]); pk.y = pg8::cvt_pk_bf16(Sacc[4 * g4 + 2], Sacc[4 * g4 + 3]);
            *(LAS u32x2*)(lds + GL_ST + img_off<128>(32 * cb + r32, 4 * rb + g4) + 8 * hh) = pk; }
        (void)gla_prep<true>(L, w2r, bb, lds);
        if (c + 1 < GLA_SEG / 64) gla_fetch<true>(L, proj, glr, b, h, t0 + 64);
        const size_t erow = (size_t)b * T + t0 + etok;
        const u32x4* gp = (const u32x4*)(proj + erow * NPROJ + C_GR + h * 128 + epart * 16); const u32x4 g0 = gp[0], g1 = gp[1];
        MrgRow mr;
        if (FUSE_MERGE) mrg_fetch(mr, a, mrow0 + (2 * c) * mstride, lane);
        __syncthreads();
        f32x16 Oa = (f32x16){};
#pragma unroll
        for (int t = 0; t < 2; ++t) if (t <= rb) {
            f32x16 X = (f32x16){};
#pragma unroll
            for (int s = 0; s < 4; ++s) X = __builtin_amdgcn_mfma_f32_32x32x16_bf16(frag_row<128>(lds + GL_KP, 32 * t, 16 * s, lane), frag_row<128>(lds + GL_QP, 32 * rb, 16 * s, lane), X, 0, 0, 0);
            if (t == rb) {
#pragma unroll
                for (int r = 0; r < 16; ++r) X[r] = crow(r, hh) <= r32 ? X[r] : 0.f; }
#pragma unroll
            for (int s2 = 0; s2 < 2; ++s2) Oa = __builtin_amdgcn_mfma_f32_32x32x16_bf16(pack8(X, s2), frag_col<256, true>(lds + GL_V, 32 * t + 16 * s2, 32 * cb, lane), Oa, 0, 0, 0);
        }
#pragma unroll
        for (int s = 0; s < 4; ++s) Oa = __builtin_amdgcn_mfma_f32_32x32x16_bf16(frag_row<128>(lds + GL_QP, 32 * rb, 16 * s, lane), frag_row<128>(lds + GL_ST, 32 * cb, 16 * s, lane), Oa, 0, 0, 0);
        gla_state_update(Sacc, lds, rb, cb, lane);
        if (FUSE_MERGE) { mrg_finish(mr, a, mrow0 + (2 * c) * mstride, lane); mrg_fetch(mr, a, mrow0 + (2 * c + 1) * mstride, lane); }
        { LAS float* ol = (LAS float*)(lds + GL_O);
#pragma unroll
          for (int r = 0; r < 16; ++r) ol[(32 * rb + crow(r, hh)) * GL_OLD + 32 * cb + r32] = Oa[r]; }
        __syncthreads();
        { const LAS float* ol = (const LAS float*)(lds + GL_O) + etok * GL_OLD + epart * 16; float ov[16]; float ss = 0.f;
#pragma unroll
          for (int q = 0; q < 4; ++q) { const f32x4 t4 = *(const LAS f32x4*)(ol + 4 * q); ov[4 * q] = t4.x; ov[4 * q + 1] = t4.y; ov[4 * q + 2] = t4.z; ov[4 * q + 3] = t4.w; ss += (t4.x * t4.x + t4.y * t4.y) + (t4.z * t4.z + t4.w * t4.w); }
          ss += __shfl_xor(ss, 1); ss += __shfl_xor(ss, 2); ss += __shfl_xor(ss, 4);
          const float rstd = rsqrtf(ss * (1.f / 128.f) + EPS);
          const size_t row = erow;
          const unsigned gw_[8] = {g0.x, g0.y, g0.z, g0.w, g1.x, g1.y, g1.z, g1.w}; float res[16];
#pragma unroll
          for (int i = 0; i < 8; ++i) { const float ga = __uint_as_float(gw_[i] << 16), gb = __uint_as_float(gw_[i] & 0xffff0000u);
              res[2 * i] = ov[2 * i] * rstd * gn[2 * i] * (ga * __builtin_amdgcn_rcpf(1.f + __expf(-ga))); res[2 * i + 1] = ov[2 * i + 1] * rstd * gn[2 * i + 1] * (gb * __builtin_amdgcn_rcpf(1.f + __expf(-gb))); }
          u32x4 o0, o1; o0.x = pk2(res[0], res[1]); o0.y = pk2(res[2], res[3]); o0.z = pk2(res[4], res[5]); o0.w = pk2(res[6], res[7]);
          o1.x = pk2(res[8], res[9]); o1.y = pk2(res[10], res[11]); o1.z = pk2(res[12], res[13]); o1.w = pk2(res[14], res[15]);
          u32x4* op = (u32x4*)(Oo + row * D + h * 128 + epart * 16); op[0] = o0; op[1] = o1; }
        if (FUSE_MERGE) mrg_finish(mr, a, mrow0 + (2 * c + 1) * mstride, lane);
    }
    __syncthreads();
}
__device__ __forceinline__ void gla_scan(const Args& a, int blk) {
    if (blk >= BATCH * 4 * 16) return;
    const int bh = blk >> 4, elem = (blk & 15) * NTHREADS + threadIdx.x, dk = elem >> 7;
    float* U = (float*)(a.ws + WS_GLAS) + (size_t)bh * GLA_NSEG * 8192 + elem; const float* A = (const float*)(a.ws + WS_GLAS_A) + (size_t)bh * GLA_NSEG * 64 + dk;
    float uv[GLA_NSEG], av[GLA_NSEG];
#pragma unroll
    for (int j = 0; j < GLA_NSEG; ++j) { uv[j] = U[(size_t)j * 8192]; av[j] = A[j * 64]; }
    float S = 0.f;
#pragma unroll
    for (int j = 0; j < GLA_NSEG; ++j) { U[(size_t)j * 8192] = S; S = av[j] * S + uv[j]; }
}
__global__ void __launch_bounds__(NTHREADS, 2) fwd(Args args) {
    extern __shared__ __attribute__((aligned(16))) unsigned char lds_raw[];
    LAS unsigned char* lds = (LAS unsigned char*)lds_raw;
    const int tid = threadIdx.x;
    const int G = gridDim.x; const int bx = blockIdx.x; const int vcu = (G % 8 == 0) ? (bx % 8) * (G / 8) + bx / 8 : bx;
    unsigned char* ws = args.ws;
    unsigned* ctl = (unsigned*)(ws + WS_CTL);
    for (int u = tid; u < (LDS_BYTES - LDSCTL_OFF) / 4; u += NTHREADS) ((LAS unsigned*)(lds + LDSCTL_OFF))[u] = 0u;
    __syncthreads();
    const int lo = args.ph_lo, hi = args.ph_hi;
    XcdBarrier bar; bar.bar = ctl + CW_BAR; bar.x = 0; bar.st = nullptr;
    if (hi - lo > 1) bar = xcd_barrier_post(ctl + CW_BAR, (volatile LAS unsigned*)(lds + LDSCTL_OFF + 64));
#define IN(k) (lo <= (k) && (k) < hi)
#define SEAM(k) do { if (IN(k) && IN((k) + 1)) xcd_barrier(bar); } while (0)
    bf16* OBR = (bf16*)args.out; float* MLp = (float*)((unsigned char*)args.out + 48 * MiB);
    if (IN(0)) { p0_prologue(args, lds, vcu, G); SEAM(0); }
    if (IN(1)) {
        constexpr int NEI = NE * 16 * 32 + NE * 8 * 32;
        const bool four = (G >= 32) && (G % 32 == 0);
        const int ngrp = four ? 4 : 1, grp = four ? (((bx & 1) << 1) | ((bx >> 1) & 1)) : 0, rank = four ? (bx >> 2) : bx, per = G / ngrp;
        const int wv = __builtin_amdgcn_readfirstlane(tid >> 6);
        const int e_lo = grp * (NEI / ngrp), e_hi = (grp + 1) * (NEI / ngrp);
        const int nu = ((M / 256) * (NPROJ / 256) + G - 1) / G, cut = four ? (nu * grp) / 3 : 0;
        pg8::DenseOrder S; S.init(ws + WS_N1, ws + WS_WIN, M, NPROJ, D, G, bx);
        pg8::EpiBf16 E{(bf16*)(ws + WS_PROJ), NPROJ};
        if (cut > 0) { pg8::RangeOrder<pg8::DenseOrder> R0{S, 0, cut}; pg8::gemm_phase<pg8::EpiBf16, pg8::RangeOrder<pg8::DenseOrder>, false>(lds, D, R0, E); __syncthreads(); }
        p0_expert_items(args, lds, e_lo + rank * NWAVES + wv, per * NWAVES, e_hi);
        __syncthreads();
        if (cut < nu) { pg8::RangeOrder<pg8::DenseOrder> R1{S, cut, nu}; pg8::gemm_phase<pg8::EpiBf16, pg8::RangeOrder<pg8::DenseOrder>, false>(lds, D, R1, E); }
        SEAM(1);
    }
    if (IN(2)) {
        for (int i = bx; i < GLA_UNITS; i += G) gla_pass1_unit(i, args, lds);
        SEAM(2);
    }
    if (IN(3)) {
        for (int blk = bx; blk < BATCH * 4 * 16; blk += G) gla_scan(args, blk);
        attn_units(bx, G, ATT_UNITS, (const bf16*)(ws + WS_PROJ), OBR, MLp, lds);
        SEAM(3);
    }
    if (IN(4)) {
        if (G == GLA_UNITS && M == 8 * NWAVES * GLA_UNITS) {
            gla_pass2_unit<true>(bx, args, lds, vcu * NWAVES + (tid >> 6), G * NWAVES);
        } else {
            const bool merge_first = (bx >> 3) & 1;
            if (merge_first) attn_merge_rows((const bf16*)args.out, (const float*)((unsigned char*)args.out + 48 * MiB), (bf16*)(ws + WS_O), vcu * NWAVES + (tid >> 6), G * NWAVES, tid & 63);
            for (int u = bx; u < GLA_UNITS; u += G) gla_pass2_unit<false>(u, args, lds);
            if (!merge_first) attn_merge_rows((const bf16*)args.out, (const float*)((unsigned char*)args.out + 48 * MiB), (bf16*)(ws + WS_O), vcu * NWAVES + (tid >> 6), G * NWAVES, tid & 63);
        }
        SEAM(4);
    }
    const bool fuse_router = ((M / 256) * (D / 256) == G);
    if (IN(5)) {
        pg8::DenseOrder S; S.init(ws + WS_O, ws + WS_WOUT, M, D, D, G, bx);
        if (fuse_router) { EpiResRouter E{args.in[0], (bf16*)(ws + WS_N2), ws, args.in[9], args.in[11]}; pg8::gemm_phase<EpiResRouter, pg8::DenseOrder, false>(lds, D, S, E); }
        else { pg8::EpiResBf16 E{args.in[0], (bf16*)(ws + WS_N2)}; pg8::gemm_phase<pg8::EpiResBf16, pg8::DenseOrder, false>(lds, D, S, E); }
        SEAM(5);
    }
    if (IN(6) && !fuse_router) { p5_router(args, lds, vcu, G); SEAM(6); }
    if (IN(7)) {
        moe_prefix(args, lds, G);
        pg8::MoeOrder S{(const LAS int*)(lds + LDS_PB), (const LAS int*)(lds + LDS_PBA), (const LAS int*)(lds + LDS_CNT), (const int*)(ws + WS_LIST), (const char*)(ws + WS_N2), (const char*)(ws + WS_W13), D, 4, G, vcu, 1, (size_t)D * D * 2};
        pg8::EpiMoeUp E{(bf16*)(ws + WS_HID), (const float*)(ws + WS_LRS), (const float*)(ws + WS_LGW), (const LAS int*)(lds + LDS_PBA)};
        pg8::gemm_phase<pg8::EpiMoeUp, pg8::MoeOrder, true>(lds, D, S, E);
        moe_tail_tasks<true>(args, lds, vcu, G);
        SEAM(7);
    }
    if (IN(8)) {
        if (!IN(7)) moe_prefix(args, lds, G);
        pg8::MoeOrder S{(const LAS int*)(lds + LDS_PB), (const LAS int*)(lds + LDS_PBA), (const LAS int*)(lds + LDS_CNT), (const int*)(ws + WS_LIST), (const char*)(ws + WS_HID), (const char*)(ws + WS_W2), FF, 4, G, vcu, 0, (size_t)D * FF * 2};
        pg8::EpiMoeDown E{(bf16*)(ws + WS_Y), (const int*)(ws + WS_LIST)};
        pg8::gemm_phase<pg8::EpiMoeDown, pg8::MoeOrder, true>(lds, FF, S, E);
        moe_tail_tasks<false>(args, lds, vcu, G);
        SEAM(8);
    }
    if (IN(9)) { p8_final(args, vcu, G, args.out); }
#undef IN
#undef SEAM
}
static void launch_fwd(const Args& base, int lo, int hi, int grid, hipStream_t stream) {
    Args a = base; a.ph_lo = lo; a.ph_hi = hi;
    hipLaunchKernelGGL(fwd, dim3(grid), dim3(NTHREADS), LDS_BYTES, stream, a);
}
extern "C" void kernel_launch(void* const* d_in, const int* in_sizes, int n_in, void* d_out, int out_size, void* d_ws, size_t ws_size, hipStream_t stream) {
    if (n_in != 16 || in_sizes[0] != M * D || out_size != M * D || ws_size < WS_END) { fprintf(stderr, "kernel_launch: unexpected shapes (n_in %d, ws %zu)\n", n_in, ws_size); return; }
    static int grid = 0;
    if (grid == 0) {
        int dev = 0, cus = 0;
        if (hipGetDevice(&dev) != hipSuccess || hipDeviceGetAttribute(&cus, hipDeviceAttributeMultiprocessorCount, dev) != hipSuccess) { grid = -1; return; }
        if (hipFuncSetAttribute((const void*)fwd, hipFuncAttributeMaxDynamicSharedMemorySize, LDS_BYTES) != hipSuccess) { fprintf(stderr, "kernel_launch: hipFuncSetAttribute failed\n"); grid = -1; return; }
        int per_cu = 0;
        if (hipOccupancyMaxActiveBlocksPerMultiprocessor(&per_cu, (const void*)fwd, NTHREADS, LDS_BYTES) != hipSuccess || per_cu < 1) fprintf(stderr, "kernel_launch: occupancy query says %d\n", per_cu);
        (void)hipGetLastError();
        grid = cus;
    }
    if (grid < 0) return;
    unsigned char* ws = (unsigned char*)d_ws; float* out = (float*)d_out;
    (void)hipMemsetAsync(ws + WS_CTL, 0, CTL_BYTES, stream);
    Args a{};
    for (int i = 0; i < 16; ++i) a.in[i] = (const float*)d_in[i];
    a.out = out; a.ws = ws;
    launch_fwd(a, 0, 10, grid, stream);
}
```
